# Optimizing an MI355X kernel written in HIP

```python
import math
import jax, jax.numpy as jnp
from jax import lax
import numpy as np

D_MODEL = 2048
BATCH = 8
SEQ = 2048
DEPTH = 4
DEC_BATCH = 8
DEC_SEQ = 16
PAST_LEN = 4096

CHUNK = 64
N_MIXERS = 3
HEAD_DIM = 128
MIX_WIDTH = 3 * D_MODEL // 4
MIX_HEADS = MIX_WIDTH // HEAD_DIM
MEM_WIDTH = D_MODEL // 4
MEM_HEADS = MEM_WIDTH // HEAD_DIM
GATE_WIDTH = MIX_WIDTH + MEM_WIDTH
N_MEM = 256
Q_BLOCK = 128
A_KV_HEADS = 4
A_WINDOW = 128
A_PREV_CHUNKS = A_WINDOW // CHUNK
T5_BUCKETS = 32
T5_MAX_DIST = 128
B_Q_RANK = 512
B_KV_RANK = 256
B_NOPE = 128
B_ROPE = 64
B_V = 128
ROPE_THETA = 10000.0
C_PREV_CHUNKS = 8
C_REL_CLIP = 128
N_A = (DEPTH + 2) // 3
N_B = (DEPTH + 1) // 3
N_C = DEPTH // 3
EPS = 1e-6
NEG_INF = -1e30
A_SPLITS = (MIX_WIDTH, A_KV_HEADS * HEAD_DIM, A_KV_HEADS * HEAD_DIM, MEM_WIDTH, GATE_WIDTH)
B_SPLITS = (B_Q_RANK, B_KV_RANK, B_ROPE, MEM_WIDTH, GATE_WIDTH)
C_SPLITS = (MIX_WIDTH, MIX_WIDTH, MIX_WIDTH, MEM_WIDTH, GATE_WIDTH)

kernel_name = "hybrid_streaming_encoder_step"


def rmsnorm(x, g):
    xf = x.astype(jnp.float32)
    y = xf * lax.rsqrt(jnp.mean(xf * xf, axis=-1, keepdims=True) + EPS)
    return (y * g.astype(jnp.float32)).astype(x.dtype)


def split_cols(z, sizes):
    idx = np.cumsum(np.array(sizes))[:-1].tolist()
    return jnp.split(z, idx, axis=-1)


def attend(q, k, v, bias, valid, sink):
    b, nq, h, d = q.shape
    kvh = k.shape[2]
    g = h // kvh
    qg = q.reshape(b, nq, kvh, g, d)
    s = jnp.einsum("bqhgd,bkhd->bhgqk", qg, k, preferred_element_type=jnp.float32) * (d ** -0.5)
    if bias is not None:
        s = s + bias.astype(jnp.float32).reshape(kvh, g, nq, bias.shape[-1])
    if valid is not None:
        s = jnp.where(valid, s, NEG_INF)
    if sink is None:
        p = jax.nn.softmax(s, axis=-1)
    else:
        sk = sink.astype(jnp.float32).reshape(kvh, g, 1, 1)
        m = jnp.maximum(jnp.max(s, axis=-1, keepdims=True), sk)
        e = jnp.exp(s - m)
        p = e / (jnp.sum(e, axis=-1, keepdims=True) + jnp.exp(sk - m))
    o = jnp.einsum("bhgqk,bkhd->bqhgd", p.astype(v.dtype), v)
    return o.reshape(b, nq, h, v.shape[-1])


def t5_bucket(rel):
    half = T5_BUCKETS // 2
    max_exact = half // 2
    ret = jnp.where(rel < 0, half, 0)
    n = jnp.abs(rel)
    nf = jnp.maximum(n, 1).astype(jnp.float32)
    large = max_exact + (jnp.log(nf / max_exact) / math.log(T5_MAX_DIST / max_exact)
                         * (half - max_exact)).astype(jnp.int32)
    large = jnp.minimum(large, half - 1)
    return ret + jnp.where(n < max_exact, n, large)


def t5_rel_bias(table, rel):
    return jnp.moveaxis(jnp.take(table, t5_bucket(rel), axis=0), -1, 0)


def clipped_rel_bias(table, rel):
    return table[:, jnp.clip(rel, -C_REL_CLIP, C_REL_CLIP) + C_REL_CLIP]


def band_attention_prompt(q, k, v, n_prev, bias, sink):
    b, s, h, d = q.shape
    pad = n_prev * CHUNK
    band = pad + CHUNK
    n_chunks = s // CHUNK
    kp = jnp.pad(k, ((0, 0), (pad, 0), (0, 0), (0, 0)))
    vp = jnp.pad(v, ((0, 0), (pad, 0), (0, 0), (0, 0)))
    qc = jnp.moveaxis(q.reshape(b, n_chunks, CHUNK, h, d), 1, 0)
    k_off = jnp.arange(band) - pad

    def one(args):
        c, qb = args
        start = c * CHUNK
        kb = lax.dynamic_slice_in_dim(kp, start, band, axis=1)
        vb = lax.dynamic_slice_in_dim(vp, start, band, axis=1)
        valid = (start + k_off >= 0)[None, :]
        return attend(qb, kb, vb, bias, valid, sink)

    out = lax.map(one, (jnp.arange(n_chunks), qc))
    return jnp.moveaxis(out, 0, 1).reshape(b, s, h, v.shape[-1])


def band_mix(q, k, v, past_k, past_v, n_prev, bias_fn, sink):
    s = q.shape[1]
    if past_k is None:
        pad = n_prev * CHUNK
        rel = jnp.arange(CHUNK)[:, None] - (jnp.arange(pad + CHUNK) - pad)[None, :]
        out = band_attention_prompt(q, k, v, n_prev, bias_fn(rel), sink)
        keep = min(pad, s)
        return out, k[:, s - keep:], v[:, s - keep:]
    p = past_k.shape[1]
    rel = (p + jnp.arange(s))[:, None] - jnp.arange(p + s)[None, :]
    out = attend(q, jnp.concatenate([past_k, k], axis=1), jnp.concatenate([past_v, v], axis=1),
                 bias_fn(rel), None, sink)
    return out, k, v


def rope_cos_sin(pos):
    half = B_ROPE // 2
    inv = ROPE_THETA ** (-jnp.arange(half, dtype=jnp.float32) / half)
    ang = pos.astype(jnp.float32)[:, None] * inv[None, :]
    return jnp.cos(ang), jnp.sin(ang)


def apply_rope(x, cos, sin):
    xf = x.astype(jnp.float32)
    x1, x2 = jnp.split(xf, 2, axis=-1)
    return jnp.concatenate([x1 * cos - x2 * sin, x1 * sin + x2 * cos], axis=-1).astype(x.dtype)


def mla_keys(c_kv, k_rope, w_kv_b, g_k):
    b, n, _ = c_kv.shape
    kv = (c_kv @ w_kv_b).reshape(b, n, MIX_HEADS, B_NOPE + B_V)
    k_nope, v = kv[..., :B_NOPE], kv[..., B_NOPE:]
    k = jnp.concatenate([k_nope, jnp.broadcast_to(k_rope[:, :, None, :], (b, n, MIX_HEADS, B_ROPE))], axis=-1)
    return rmsnorm(k, g_k), v


def mla_prompt_attend(q, k, v):
    b, s, h, d = q.shape
    nb = s // Q_BLOCK
    qb = jnp.moveaxis(q.reshape(b, nb, Q_BLOCK, h, d), 1, 0)
    k_chunk = jnp.arange(s) // CHUNK

    def one(args):
        i, qblk = args
        q_chunk = (i * Q_BLOCK + jnp.arange(Q_BLOCK)) // CHUNK
        valid = k_chunk[None, :] <= q_chunk[:, None]
        return attend(qblk, k, v, None, valid, None)

    out = lax.map(one, (jnp.arange(nb), qb))
    return jnp.moveaxis(out, 0, 1).reshape(b, s, h, v.shape[-1])


def memory_kv(mem, g_mem, w_mem_kv, g_xk):
    b, n, _ = mem.shape
    kv = rmsnorm(mem, g_mem) @ w_mem_kv
    k = rmsnorm(kv[..., :MEM_WIDTH].reshape(b, n, MEM_HEADS, HEAD_DIM), g_xk)
    v = kv[..., MEM_WIDTH:].reshape(b, n, MEM_HEADS, HEAD_DIM)
    return k, v


def merge_and_project(x, mix_out, xq, gate, mem_k, mem_v, g_xq, w_out):
    b, s, _ = x.shape
    xq = rmsnorm(xq.reshape(b, s, MEM_HEADS, HEAD_DIM), g_xq)
    x_out = attend(xq, mem_k, mem_v, None, None, None)
    o = jnp.concatenate([mix_out.reshape(b, s, MIX_WIDTH), x_out.reshape(b, s, MEM_WIDTH)], axis=-1)
    return x + (o * jax.nn.silu(gate)) @ w_out


def layer_a(x, past_k, past_v, g_norm, w_in, g_q, g_k, sink, t5_table, mem_k, mem_v, g_xq, w_out):
    b, s, _ = x.shape
    q, k, v, xq, gate = split_cols(rmsnorm(x, g_norm) @ w_in, A_SPLITS)
    q = rmsnorm(q.reshape(b, s, MIX_HEADS, HEAD_DIM), g_q)
    k = rmsnorm(k.reshape(b, s, A_KV_HEADS, HEAD_DIM), g_k)
    v = v.reshape(b, s, A_KV_HEADS, HEAD_DIM)
    out, new_k, new_v = band_mix(q, k, v, past_k, past_v, A_PREV_CHUNKS,
                                 lambda rel: t5_rel_bias(t5_table, rel), sink)
    y = merge_and_project(x, out, xq, gate, mem_k, mem_v, g_xq, w_out)
    return y, new_k, new_v


def layer_b(x, pos, past_ckv, past_krope, g_norm, w_in, g_cq, w_q_b, g_ckv, w_kv_b, g_q, g_k,
            mem_k, mem_v, g_xq, w_out):
    b, s, _ = x.shape
    c_q, c_kv, k_rope, xq, gate = split_cols(rmsnorm(x, g_norm) @ w_in, B_SPLITS)
    cos, sin = rope_cos_sin(pos)
    q = (rmsnorm(c_q, g_cq) @ w_q_b).reshape(b, s, MIX_HEADS, B_NOPE + B_ROPE)
    q = jnp.concatenate([q[..., :B_NOPE], apply_rope(q[..., B_NOPE:], cos[:, None, :], sin[:, None, :])], axis=-1)
    q = rmsnorm(q, g_q)
    c_kv = rmsnorm(c_kv, g_ckv)
    k_rope = apply_rope(k_rope, cos, sin)
    if past_ckv is None:
        k, v = mla_keys(c_kv, k_rope, w_kv_b, g_k)
        out = mla_prompt_attend(q, k, v)
    else:
        k, v = mla_keys(jnp.concatenate([past_ckv, c_kv], axis=1),
                        jnp.concatenate([past_krope, k_rope], axis=1), w_kv_b, g_k)
        out = attend(q, k, v, None, None, None)
    y = merge_and_project(x, out, xq, gate, mem_k, mem_v, g_xq, w_out)
    return y, c_kv, k_rope


def layer_c(x, past_k, past_v, g_norm, w_in, g_q, g_k, rel_table, mem_k, mem_v, g_xq, w_out):
    b, s, _ = x.shape
    q, k, v, xq, gate = split_cols(rmsnorm(x, g_norm) @ w_in, C_SPLITS)
    q = rmsnorm(q.reshape(b, s, MIX_HEADS, HEAD_DIM), g_q)
    k = rmsnorm(k.reshape(b, s, MIX_HEADS, HEAD_DIM), g_k)
    v = v.reshape(b, s, MIX_HEADS, HEAD_DIM)
    out, new_k, new_v = band_mix(q, k, v, past_k, past_v, C_PREV_CHUNKS,
                                 lambda rel: clipped_rel_bias(rel_table, rel), None)
    y = merge_and_project(x, out, xq, gate, mem_k, mem_v, g_xq, w_out)
    return y, new_k, new_v


def setup_inputs(seed: int = 0) -> dict:
    key = jax.random.key(seed)
    keys = iter(jax.random.split(key, 40))

    def nrm(shape, scale):
        return jax.random.normal(next(keys), shape, jnp.float32) * scale

    def gain(shape):
        return 1.0 + nrm(shape, 0.02)

    a_rows = min(A_WINDOW, PAST_LEN)
    c_rows = min(C_PREV_CHUNKS * CHUNK, PAST_LEN)
    d_in = D_MODEL ** -0.5
    return {
        "x_prompt": nrm((BATCH, SEQ, D_MODEL), 1.0),
        "x_sample": nrm((DEC_BATCH, DEC_SEQ, D_MODEL), 1.0),
        "mem_prompt": nrm((BATCH, N_MEM, D_MODEL), 1.0),
        "cache_a_k": nrm((N_A, DEC_BATCH, a_rows, A_KV_HEADS, HEAD_DIM), 1.0),
        "cache_a_v": nrm((N_A, DEC_BATCH, a_rows, A_KV_HEADS, HEAD_DIM), 1.0),
        "cache_b_ckv": nrm((N_B, DEC_BATCH, PAST_LEN, B_KV_RANK), 1.0),
        "cache_b_krope": nrm((N_B, DEC_BATCH, PAST_LEN, B_ROPE), 1.0),
        "cache_c_k": nrm((N_C, DEC_BATCH, c_rows, MIX_HEADS, HEAD_DIM), 1.0),
        "cache_c_v": nrm((N_C, DEC_BATCH, c_rows, MIX_HEADS, HEAD_DIM), 1.0),
        "cache_mem_k": nrm((DEPTH, DEC_BATCH, N_MEM, MEM_HEADS, HEAD_DIM), 1.0),
        "cache_mem_v": nrm((DEPTH, DEC_BATCH, N_MEM, MEM_HEADS, HEAD_DIM), 1.0),
        "t5_bias": nrm((T5_BUCKETS, MIX_HEADS), 0.5),
        "norm_g": gain((DEPTH, D_MODEL)),
        "w_out": nrm((DEPTH, GATE_WIDTH, D_MODEL), GATE_WIDTH ** -0.5),
        "mem_norm_g": gain((DEPTH, D_MODEL)),
        "w_mem_kv": nrm((DEPTH, D_MODEL, 2 * MEM_WIDTH), d_in),
        "xq_norm_g": gain((DEPTH, HEAD_DIM)),
        "xk_norm_g": gain((DEPTH, HEAD_DIM)),
        "a_w_in": nrm((N_A, D_MODEL, sum(A_SPLITS)), d_in),
        "a_q_norm_g": gain((N_A, HEAD_DIM)),
        "a_k_norm_g": gain((N_A, HEAD_DIM)),
        "a_sink": nrm((N_A, MIX_HEADS), 0.5),
        "b_w_in": nrm((N_B, D_MODEL, sum(B_SPLITS)), d_in),
        "b_cq_norm_g": gain((N_B, B_Q_RANK)),
        "b_w_q_b": nrm((N_B, B_Q_RANK, MIX_HEADS * (B_NOPE + B_ROPE)), B_Q_RANK ** -0.5),
        "b_ckv_norm_g": gain((N_B, B_KV_RANK)),
        "b_w_kv_b": nrm((N_B, B_KV_RANK, MIX_HEADS * (B_NOPE + B_V)), B_KV_RANK ** -0.5),
        "b_q_norm_g": gain((N_B, B_NOPE + B_ROPE)),
        "b_k_norm_g": gain((N_B, B_NOPE + B_ROPE)),
        "c_w_in": nrm((N_C, D_MODEL, sum(C_SPLITS)), d_in),
        "c_q_norm_g": gain((N_C, HEAD_DIM)),
        "c_k_norm_g": gain((N_C, HEAD_DIM)),
        "c_rel_bias": nrm((N_C, MIX_HEADS, 2 * C_REL_CLIP + 1), 0.5),
    }


def reference(x_prompt, x_sample, mem_prompt, cache_a_k, cache_a_v, cache_b_ckv, cache_b_krope,
              cache_c_k, cache_c_v, cache_mem_k, cache_mem_v, t5_bias, norm_g, w_out, mem_norm_g,
              w_mem_kv, xq_norm_g, xk_norm_g, a_w_in, a_q_norm_g, a_k_norm_g, a_sink, b_w_in,
              b_cq_norm_g, b_w_q_b, b_ckv_norm_g, b_w_kv_b, b_q_norm_g, b_k_norm_g, c_w_in,
              c_q_norm_g, c_k_norm_g, c_rel_bias):
    past = cache_b_ckv.shape[2]
    pos_p = jnp.arange(x_prompt.shape[1])
    pos_s = past + jnp.arange(x_sample.shape[1])
    yp, ys = x_prompt, x_sample
    a_kp, a_vp, a_ks, a_vs = [], [], [], []
    b_cp, b_rp, b_cs, b_rs = [], [], [], []
    c_kp, c_vp, c_ks, c_vs = [], [], [], []
    m_k, m_v = [], []
    for i in range(DEPTH):
        kind, j = i % N_MIXERS, i // N_MIXERS
        mk, mv = memory_kv(mem_prompt, mem_norm_g[i], w_mem_kv[i], xk_norm_g[i])
        m_k.append(mk)
        m_v.append(mv)
        if kind == 0:
            yp, kn, vn = layer_a(yp, None, None, norm_g[i], a_w_in[j], a_q_norm_g[j], a_k_norm_g[j],
                                 a_sink[j], t5_bias, mk, mv, xq_norm_g[i], w_out[i])
            a_kp.append(kn)
            a_vp.append(vn)
            ys, kn, vn = layer_a(ys, cache_a_k[j], cache_a_v[j], norm_g[i], a_w_in[j], a_q_norm_g[j],
                                 a_k_norm_g[j], a_sink[j], t5_bias, cache_mem_k[i], cache_mem_v[i],
                                 xq_norm_g[i], w_out[i])
            a_ks.append(kn)
            a_vs.append(vn)
        elif kind == 1:
            yp, cn, rn = layer_b(yp, pos_p, None, None, norm_g[i], b_w_in[j], b_cq_norm_g[j], b_w_q_b[j],
                                 b_ckv_norm_g[j], b_w_kv_b[j], b_q_norm_g[j], b_k_norm_g[j],
                                 mk, mv, xq_norm_g[i], w_out[i])
            b_cp.append(cn)
            b_rp.append(rn)
            ys, cn, rn = layer_b(ys, pos_s, cache_b_ckv[j], cache_b_krope[j], norm_g[i], b_w_in[j],
                                 b_cq_norm_g[j], b_w_q_b[j], b_ckv_norm_g[j], b_w_kv_b[j],
                                 b_q_norm_g[j], b_k_norm_g[j], cache_mem_k[i], cache_mem_v[i],
                                 xq_norm_g[i], w_out[i])
            b_cs.append(cn)
            b_rs.append(rn)
        else:
            yp, kn, vn = layer_c(yp, None, None, norm_g[i], c_w_in[j], c_q_norm_g[j], c_k_norm_g[j],
                                 c_rel_bias[j], mk, mv, xq_norm_g[i], w_out[i])
            c_kp.append(kn)
            c_vp.append(vn)
            ys, kn, vn = layer_c(ys, cache_c_k[j], cache_c_v[j], norm_g[i], c_w_in[j], c_q_norm_g[j],
                                 c_k_norm_g[j], c_rel_bias[j], cache_mem_k[i], cache_mem_v[i],
                                 xq_norm_g[i], w_out[i])
            c_ks.append(kn)
            c_vs.append(vn)
    return (yp, ys,
            jnp.stack(a_kp), jnp.stack(a_vp), jnp.stack(a_ks), jnp.stack(a_vs),
            jnp.stack(b_cp), jnp.stack(b_rp), jnp.stack(b_cs), jnp.stack(b_rs),
            jnp.stack(c_kp), jnp.stack(c_vp), jnp.stack(c_ks), jnp.stack(c_vs),
            jnp.stack(m_k), jnp.stack(m_v))
```

```cpp
#include <hip/hip_runtime.h>
#include <hip/hip_cooperative_groups.h>
#include <cstdio>
#include <cstdint>
namespace cg = cooperative_groups;

#define LAS __attribute__((address_space(3)))
typedef unsigned short bf16_t;
typedef short bf16x8 __attribute__((ext_vector_type(8)));
typedef float f32x4 __attribute__((ext_vector_type(4)));
typedef unsigned u32x4 __attribute__((ext_vector_type(4)));
typedef unsigned u32x2 __attribute__((ext_vector_type(2)));

constexpr int SEQ = 2048, NB = 8, DEC = 16, PAST = 4096, DM = 2048;
constexpr int NP = NB * SEQ;
constexpr int NR = NP + NB * DEC;
constexpr int MT = 16640;
constexpr int KVB = PAST + DEC;
constexpr int KVB_ROWS = 33024;
constexpr int RSD_LD = 4128;
constexpr float EPS = 1e-6f;
constexpr float LOG2E = 1.4426950408889634f;

constexpr size_t O_YP = 0, O_YS = 33554432, O_AKP = O_YS + 262144, O_AVP = O_AKP + 1048576, O_AKS = O_AVP + 1048576, O_AVS = O_AKS + 131072,
    O_BCP = O_AVS + 131072, O_BRP = O_BCP + 4194304, O_BCS = O_BRP + 1048576, O_BRS = O_BCS + 32768, O_CKP = O_BRS + 8192, O_CVP = O_CKP + 6291456,
    O_CKS = O_CVP + 6291456, O_CVS = O_CKS + 196608, O_MK = O_CVS + 196608, O_MV = O_MK + 4194304, O_END = O_MV + 4194304;

constexpr size_t MiB = 1u << 20;
constexpr size_t WS_WIN = 0, WS_WOUT = 28 * MiB, WS_WQB = 36 * MiB, WS_WK = WS_WQB + 2304 * 512 * 2, WS_WV = WS_WK + 1536 * 256 * 2;
constexpr size_t WS_XN = 40 * MiB;
constexpr size_t WS_KMEM = 105 * MiB, WS_VFMEM = 113 * MiB, WS_KCMEM = 121 * MiB, WS_VFCMEM = 129 * MiB;
constexpr size_t WS_KDA = 137 * MiB, WS_VFDA = 140 * MiB, WS_KDC = 143 * MiB, WS_VFDC = 156 * MiB, WS_CKVD = 169 * MiB, WS_KRD = 186 * MiB,
    WS_RSTDD = 191 * MiB, WS_TB = 193 * MiB, WS_BAR = 193 * MiB + 512 * 1024, WS_DYN = 194 * MiB;
constexpr size_t KDA_L = 8 * 160 * 512, VFDA_L = 8 * 4 * 5 * 4096;
constexpr size_t DY_MEMN = 200 * MiB, DY_ZM = 208 * MiB, DY_WMEM = 224 * MiB;
constexpr size_t DY_VFA = 164 * MiB, DY_VFC = 228 * MiB;
constexpr size_t DY_QB = 0, DY_ZB = 74 * MiB, DY_KP = 188 * MiB, DY_VP = 236 * MiB, DY_KRP = 286 * MiB, DY_RSTDP = 288 * MiB;
constexpr size_t DY_KDEC = 76 * MiB, DY_VDEC = 188 * MiB;
constexpr size_t VFDEC_B = (size_t)12 * 129 * 4096 * 2;
constexpr size_t WS_PART = WS_DYN + 290 * MiB;
constexpr size_t WS_NEED = WS_DYN + 298 * MiB;

struct KP { const float* in[33]; float* out; unsigned char* ws; };

__device__ __forceinline__ unsigned cvt_pk_bf16(float lo, float hi) { unsigned r; asm volatile("v_cvt_pk_bf16_f32 %0, %1, %2" : "=v"(r) : "v"(lo), "v"(hi)); return r; }
__device__ __forceinline__ unsigned f2bf(float f) { return cvt_pk_bf16(f, 0.f) & 0xffffu; }
__device__ __forceinline__ float bflo(unsigned u) { return __builtin_bit_cast(float, u << 16); }
__device__ __forceinline__ float bfhi(unsigned u) { return __builtin_bit_cast(float, u & 0xffff0000u); }
__device__ __forceinline__ float bf1(bf16_t u) { return __builtin_bit_cast(float, ((unsigned)u) << 16); }
__device__ __forceinline__ void unpack8(u32x4 u, float (&f)[8]) { f[0] = bflo(u.x); f[1] = bfhi(u.x); f[2] = bflo(u.y); f[3] = bfhi(u.y); f[4] = bflo(u.z); f[5] = bfhi(u.z); f[6] = bflo(u.w); f[7] = bfhi(u.w); }
__device__ __forceinline__ u32x4 pack8(const float (&f)[8]) { u32x4 r; r.x = cvt_pk_bf16(f[0], f[1]); r.y = cvt_pk_bf16(f[2], f[3]); r.z = cvt_pk_bf16(f[4], f[5]); r.w = cvt_pk_bf16(f[6], f[7]); return r; }
__device__ __forceinline__ void load8(const bf16_t* p, float (&f)[8]) { unpack8(*(const u32x4*)p, f); }
__device__ __forceinline__ void load8(const float* p, float (&f)[8]) { f32x4 a = *(const f32x4*)p, b = *(const f32x4*)(p + 4); f[0] = a[0]; f[1] = a[1]; f[2] = a[2]; f[3] = a[3]; f[4] = b[0]; f[5] = b[1]; f[6] = b[2]; f[7] = b[3]; }
__device__ __forceinline__ void store8f(float* p, const float (&f)[8]) { *(f32x4*)p = (f32x4){f[0], f[1], f[2], f[3]}; *(f32x4*)(p + 4) = (f32x4){f[4], f[5], f[6], f[7]}; }
template <int G> __device__ __forceinline__ float gsum(float v) {
#pragma unroll
    for (int o = 1; o < G; o <<= 1) v += __shfl_xor(v, o);
    return v;
}
__device__ __forceinline__ float sumsq8(const float (&f)[8]) { float s = 0.f;
#pragma unroll
    for (int e = 0; e < 8; ++e) s += f[e] * f[e];
    return s; }
__device__ __forceinline__ void wave_lds_fence() { asm volatile("s_waitcnt lgkmcnt(0)" ::: "memory"); __builtin_amdgcn_wave_barrier(); }
__device__ __forceinline__ float fexp2(float x) { return __builtin_amdgcn_exp2f(x); }

namespace pg8 {
constexpr int BM = 256, BK = 64, HALF = 128, HTB = HALF * BK * 2, NXCD = 8, WGM = 16;
__device__ __forceinline__ int lds_byte(int r, int c) { const int st = (r >> 4) * 2 + (c >> 5), rr = r & 15, cc = c & 31, ob = rr * 64 + cc * 2; return st * 1024 + (ob ^ (((ob >> 9) & 1) << 5)); }
__device__ __forceinline__ void stage_rc(int b, int& R, int& C) { const int st = b / 1024, sb = b % 1024, swz = sb ^ (((sb >> 9) & 1) << 5); R = (st >> 1) * 16 + swz / 64; C = (st & 1) * 32 + (swz % 64) / 2; }
__device__ __forceinline__ int perm32(int rho) { const int n = rho >> 4, i = rho & 15; return 8 * (i >> 2) + 4 * n + (i & 3); }
struct Unit { int pm, pn; };
struct GemmDesc { const bf16_t* A; const bf16_t* Bt; void* C; const void* R; int rbf, cbf;
  size_t sAm, sBm, sCm; int lda, ldb, ldc, nM, nN, K, epi, mvalid, rot; };
struct StaticOrder {
    int nM, nN, nwg, G, c;
    __device__ void init(int nM_, int nN_, int G_, int c_) { nM = nM_; nN = nN_; nwg = nM * nN; G = G_; c = c_; }
    __device__ bool next(int i, Unit& u) const {
        const long L = (long)i * G + c; if (L >= nwg) return false;
        int wgid = (int)L; { const int q = nwg / NXCD, r = nwg % NXCD, xcd = wgid % NXCD, off = wgid / NXCD; wgid = (xcd < r ? xcd * (q + 1) : r * (q + 1) + (xcd - r) * q) + off; }
        const int nig = WGM * nN, gid = wgid / nig, fm = gid * WGM, gsz = (nM - fm) < WGM ? (nM - fm) : WGM;
        u.pm = fm + ((wgid % nig) % gsz); u.pn = (wgid % nig) / gsz; return true;
    }
};
__device__ __forceinline__ void epilogue(const f32x4 (&acc)[2][2][4][2], const GemmDesc& g, const Unit& u, int wr, int wc, int fr, int fq) {
    const int row0 = u.pm * BM + wr * 64 + fr, col0 = u.pn * BM + wc * 32 + 8 * fq;
    if (g.epi == 0) {
        bf16_t* O = (bf16_t*)g.C;
#pragma unroll
        for (int ai = 0; ai < 2; ++ai)
#pragma unroll
            for (int m = 0; m < 4; ++m) { bf16_t* rowp = O + (size_t)(row0 + ai * HALF + m * 16) * g.ldc + col0;
#pragma unroll
                for (int bj = 0; bj < 2; ++bj) { const f32x4 v0 = acc[ai][bj][m][0], v1 = acc[ai][bj][m][1]; u32x4 w; w.x = cvt_pk_bf16(v0[0], v0[1]); w.y = cvt_pk_bf16(v0[2], v0[3]); w.z = cvt_pk_bf16(v1[0], v1[1]); w.w = cvt_pk_bf16(v1[2], v1[3]);
                    *(u32x4*)(rowp + bj * HALF) = w; } }
    } else if (g.epi == 1) {
#pragma unroll
        for (int ai = 0; ai < 2; ++ai)
#pragma unroll
        for (int mh = 0; mh < 2; ++mh) {
            f32x4 ra[2][2], rb[2][2];
            if (g.rbf) {
                u32x4 rv[2][2];
#pragma unroll
                for (int mm = 0; mm < 2; ++mm)
#pragma unroll
                    for (int bj = 0; bj < 2; ++bj) { const int row = row0 + ai * HALF + (mh * 2 + mm) * 16; const size_t off = (size_t)(row < g.mvalid ? row : 0) * g.ldc + col0 + bj * HALF;
                        rv[mm][bj] = *(const u32x4*)((const bf16_t*)g.R + off); }
#pragma unroll
                for (int mm = 0; mm < 2; ++mm)
#pragma unroll
                    for (int bj = 0; bj < 2; ++bj) { const u32x4 v = rv[mm][bj]; ra[mm][bj] = (f32x4){bflo(v.x), bfhi(v.x), bflo(v.y), bfhi(v.y)}; rb[mm][bj] = (f32x4){bflo(v.z), bfhi(v.z), bflo(v.w), bfhi(v.w)}; }
            } else {
#pragma unroll
                for (int mm = 0; mm < 2; ++mm)
#pragma unroll
                    for (int bj = 0; bj < 2; ++bj) { const int row = row0 + ai * HALF + (mh * 2 + mm) * 16; const size_t off = (size_t)(row < g.mvalid ? row : 0) * g.ldc + col0 + bj * HALF;
                        ra[mm][bj] = *(const f32x4*)((const float*)g.R + off); rb[mm][bj] = *(const f32x4*)((const float*)g.R + off + 4); }
            }
#pragma unroll
            for (int mm = 0; mm < 2; ++mm) { const int m = mh * 2 + mm; const int row = row0 + ai * HALF + m * 16; if (row < g.mvalid) { const size_t off = (size_t)row * g.ldc + col0;
#pragma unroll
                for (int bj = 0; bj < 2; ++bj) { const f32x4 a = ra[mm][bj] + acc[ai][bj][m][0], b = rb[mm][bj] + acc[ai][bj][m][1];
                    if (g.cbf) { u32x4 w; w.x = cvt_pk_bf16(a[0], a[1]); w.y = cvt_pk_bf16(a[2], a[3]); w.z = cvt_pk_bf16(b[0], b[1]); w.w = cvt_pk_bf16(b[2], b[3]); *(u32x4*)((bf16_t*)g.C + off + bj * HALF) = w; }
                    else { *(f32x4*)((float*)g.C + off + bj * HALF) = a; *(f32x4*)((float*)g.C + off + bj * HALF + 4) = b; } } } }
        }
    } else {
        float* O = (float*)g.C + (size_t)u.pm * g.sCm;
#pragma unroll
        for (int m = 0; m < 4; ++m) { float* rowp = O + (size_t)(wr * 64 + fr + m * 16) * g.ldc + col0;
#pragma unroll
            for (int bj = 0; bj < 2; ++bj) { *(f32x4*)(rowp + bj * HALF) = acc[0][bj][m][0]; *(f32x4*)(rowp + bj * HALF + 4) = acc[0][bj][m][1]; } }
    }
}
__device__ __forceinline__ void gemm_phase(LAS unsigned char* lds, const GemmDesc g, const StaticOrder& S) {
    const int tid = threadIdx.x, wid = __builtin_amdgcn_readfirstlane(tid >> 6), lane = tid & 63, wr = wid >> 2, wc = wid & 3, fr = lane & 15, fq = lane >> 4;
    const int K = g.K, nt = K / BK;
    unsigned voffA[2], voffB[2];
#pragma unroll
    for (int i = 0; i < 2; ++i) { int R, C; stage_rc(tid * 16 + i * 8192, R, C); const int Rb = (R & ~31) + perm32(R & 31);
        voffA[i] = (unsigned)(R * g.lda + C) * 2u; voffB[i] = (unsigned)(Rb * g.ldb + C) * 2u; }
    const size_t kstep = (size_t)(BK * 2);
    const size_t hstepA = (size_t)HALF * g.lda * 2, hstepB = (size_t)HALF * g.ldb * 2;
    const size_t tstepB = 2 * hstepB;
    const unsigned ldsw = (unsigned)wid * 1024u;
    const int aoff = lds_byte(wr * 64 + fr, fq * 8), boff = lds_byte(wc * 32 + fr, fq * 8);
#define PG8_SA(b, h) (((b) * 2 + (h)) * HTB)
#define PG8_SB(b, h) ((4 + (b) * 2 + (h)) * HTB)
#define PG8_STAGE(bufoff, gbase, voff) do { _Pragma("unroll") for (int _i = 0; _i < 2; ++_i) \
        __builtin_amdgcn_global_load_lds((const unsigned*)((const char*)(gbase) + (voff)[_i]), (LAS unsigned*)(lds + (bufoff) + ldsw + _i * 8192), 16, 0, 0); } while (0)
#define PG8_LDA(dst, b, h) do { _Pragma("unroll") for (int m = 0; m < 4; ++m) _Pragma("unroll") for (int k = 0; k < 2; ++k) dst[m][k] = *(const LAS bf16x8*)(lds + PG8_SA(b, h) + aoff + m * 2048 + k * 1024); } while (0)
#define PG8_LDB(dst, b, h) do { _Pragma("unroll") for (int n = 0; n < 2; ++n) _Pragma("unroll") for (int k = 0; k < 2; ++k) dst[n][k] = *(const LAS bf16x8*)(lds + PG8_SB(b, h) + boff + n * 2048 + k * 1024); } while (0)
#define PG8_MMA(ai, bj, At, Bt) do { __builtin_amdgcn_s_setprio(1); _Pragma("unroll") for (int m = 0; m < 4; ++m) _Pragma("unroll") for (int n = 0; n < 2; ++n) _Pragma("unroll") for (int k = 0; k < 2; ++k) \
        acc[ai][bj][m][n] = __builtin_amdgcn_mfma_f32_16x16x32_bf16(Bt[n][k], At[m][k], acc[ai][bj][m][n], 0, 0, 0); __builtin_amdgcn_s_setprio(0); } while (0)
#define PG8_WAIT_V(n) asm volatile("s_waitcnt vmcnt(" #n ")" ::: "memory")
#define PG8_WAIT_L(n) asm volatile("s_waitcnt lgkmcnt(" #n ")" ::: "memory")
#define PG8_BAR __builtin_amdgcn_s_barrier()
#define PG8_SCHED __builtin_amdgcn_sched_barrier(0)
    Unit cur, nxt; int ui = 0;
    if (!S.next(0, cur)) return;
    f32x4 acc[2][2][4][2];
#pragma unroll
    for (int a = 0; a < 2; ++a)
#pragma unroll
        for (int b = 0; b < 2; ++b)
#pragma unroll
            for (int m = 0; m < 4; ++m)
#pragma unroll
                for (int n = 0; n < 2; ++n) acc[a][b][m][n] = (f32x4){0.f, 0.f, 0.f, 0.f};
    bf16x8 At[4][2], B0[2][2], B1[2][2];
    const char* cA = (const char*)g.A + (size_t)cur.pm * g.sAm; const char* cB = (const char*)g.Bt + (size_t)cur.pn * tstepB + (size_t)cur.pm * g.sBm;
    PG8_STAGE(PG8_SB(0, 0), cB, voffB); PG8_STAGE(PG8_SB(0, 1), cB + hstepB, voffB); PG8_STAGE(PG8_SA(0, 0), cA, voffA); PG8_STAGE(PG8_SA(0, 1), cA + hstepA, voffA);
    if (wr == 1) PG8_BAR;
    PG8_WAIT_V(2); PG8_BAR;
    PG8_STAGE(PG8_SB(1, 0), cB + kstep, voffB); PG8_STAGE(PG8_SA(1, 0), cA + kstep, voffA); PG8_STAGE(PG8_SB(1, 1), cB + hstepB + kstep, voffB);
    PG8_WAIT_V(6); PG8_BAR;
    for (;;) {
        const bool has_next = S.next(ui + 1, nxt);
        const char* nA = has_next ? (const char*)g.A + (size_t)nxt.pm * g.sAm : cA; const char* nB = has_next ? (const char*)g.Bt + (size_t)nxt.pn * tstepB + (size_t)nxt.pm * g.sBm : cB;
        for (int t = 0; t < nt; t += 2) {
            const bool last = (t == nt - 2);
            const char* a1 = cA + (size_t)(t + 1) * kstep;
            const char* a2 = last ? nA : cA + (size_t)(t + 2) * kstep; const char* b2 = last ? nB : cB + (size_t)(t + 2) * kstep;
            const char* a3 = a2 + kstep; const char* b3 = b2 + kstep;
            PG8_LDB(B0, 0, 0); PG8_LDB(B1, 0, 1); PG8_SCHED; PG8_LDA(At, 0, 0); PG8_STAGE(PG8_SA(1, 1), a1 + hstepA, voffA);
            PG8_WAIT_V(8); PG8_WAIT_L(0); PG8_BAR; PG8_MMA(0, 0, At, B0); PG8_MMA(0, 1, At, B1); PG8_BAR; PG8_SCHED;
            PG8_LDA(At, 0, 1); PG8_STAGE(PG8_SB(0, 0), b2, voffB); PG8_STAGE(PG8_SB(0, 1), b2 + hstepB, voffB); PG8_STAGE(PG8_SA(0, 0), a2, voffA);
            PG8_WAIT_V(8); PG8_WAIT_L(0); PG8_BAR; PG8_MMA(1, 0, At, B0); PG8_MMA(1, 1, At, B1); PG8_BAR; PG8_SCHED;
            PG8_LDB(B0, 1, 0); PG8_LDB(B1, 1, 1); PG8_SCHED; PG8_LDA(At, 1, 0); PG8_STAGE(PG8_SA(0, 1), a2 + hstepA, voffA);
            PG8_WAIT_V(8); PG8_WAIT_L(0); PG8_BAR; PG8_MMA(0, 0, At, B0); PG8_MMA(0, 1, At, B1); PG8_BAR; PG8_SCHED;
            PG8_LDA(At, 1, 1); PG8_STAGE(PG8_SB(1, 0), b3, voffB); PG8_STAGE(PG8_SB(1, 1), b3 + hstepB, voffB); PG8_STAGE(PG8_SA(1, 0), a3, voffA);
            PG8_WAIT_V(8); PG8_WAIT_L(0); PG8_BAR; PG8_MMA(1, 0, At, B0); PG8_MMA(1, 1, At, B1); PG8_BAR; PG8_SCHED;
        }
        if (wr == 0) PG8_BAR;
        epilogue(acc, g, cur, wr, wc, fr, fq);
        if (!has_next) break;
#pragma unroll
        for (int a = 0; a < 2; ++a)
#pragma unroll
            for (int b = 0; b < 2; ++b)
#pragma unroll
                for (int m = 0; m < 4; ++m)
#pragma unroll
                    for (int n = 0; n < 2; ++n) acc[a][b][m][n] = (f32x4){0.f, 0.f, 0.f, 0.f};
        cur = nxt; cA = nA; cB = nB; ++ui;
        if (wr == 1) PG8_BAR;
    }
    PG8_WAIT_V(0);
    PG8_BAR;
#undef PG8_SA
#undef PG8_SB
#undef PG8_STAGE
#undef PG8_LDA
#undef PG8_LDB
#undef PG8_MMA
#undef PG8_WAIT_V
#undef PG8_WAIT_L
#undef PG8_BAR
#undef PG8_SCHED
}
}
using pg8::GemmDesc;

__device__ __forceinline__ void wtrans_tile(const float* src, int ldsrc, int k0, int n0, const float* gain, bf16_t* dst, int ldd, LAS bf16_t* T, int lane) {
#pragma unroll 16
    for (int i = 0; i < 64; ++i) {
        float v = src[(size_t)(k0 + i) * ldsrc + n0 + lane];
        if (gain) v *= gain[k0 + i];
        T[lane * 72 + i] = (bf16_t)f2bf(v);
    }
    wave_lds_fence();
#pragma unroll
    for (int it = 0; it < 8; ++it) { const int n = it * 8 + (lane >> 3), kc = (lane & 7) * 8; const u32x4 v = *(const LAS u32x4*)(T + n * 72 + kc); *(u32x4*)(dst + (size_t)n * ldd + kc) = v; }
    wave_lds_fence();
}
template <class T> __device__ __forceinline__ void vrelayout(const T* src, int ld, int nkeys, bf16_t* dstblk, float* fout, int fld, LAS bf16_t* Sx, int lane) {
    const int r = lane & 15, g = lane >> 4;
    for (int i = 0; i < nkeys / 4; ++i) { const int key = i * 4 + g; float f[8]; load8(src + (size_t)key * ld + r * 8, f);
        if (fout) store8f(fout + (size_t)key * fld + r * 8, f);
        *(LAS u32x4*)(Sx + key * 136 + r * 8) = pack8(f); }
    wave_lds_fence();
#pragma unroll
    for (int dt = 0; dt < 8; ++dt) {
        unsigned w[4];
#pragma unroll
        for (int p = 0; p < 4; ++p) { const int key = 8 * g + 2 * p;
            const unsigned lo = Sx[key * 136 + dt * 16 + r], hi = Sx[(key + 1) * 136 + dt * 16 + r]; w[p] = lo | (hi << 16); }
        bf16_t* d = dstblk + (dt * 64 + lane) * 8;
        if (nkeys == 32 || g < 2) *(u32x4*)d = (u32x4){w[0], w[1], w[2], w[3]}; else *(u32x4*)d = (u32x4){0u, 0u, 0u, 0u};
    }
    wave_lds_fence();
}

__device__ __forceinline__ float gmax4(float v) {
    unsigned u = __builtin_bit_cast(unsigned, v);
    auto a = __builtin_amdgcn_permlane16_swap(u, u, false, false);
    float m = fmaxf(__builtin_bit_cast(float, (unsigned)a[0]), __builtin_bit_cast(float, (unsigned)a[1]));
    u = __builtin_bit_cast(unsigned, m);
    auto b = __builtin_amdgcn_permlane32_swap(u, u, false, false);
    return fmaxf(__builtin_bit_cast(float, (unsigned)b[0]), __builtin_bit_cast(float, (unsigned)b[1]));
}
__device__ __forceinline__ float gsum4(float v) {
    unsigned u = __builtin_bit_cast(unsigned, v);
    auto a = __builtin_amdgcn_permlane16_swap(u, u, false, false);
    float m = __builtin_bit_cast(float, (unsigned)a[0]) + __builtin_bit_cast(float, (unsigned)a[1]);
    u = __builtin_bit_cast(unsigned, m);
    auto b = __builtin_amdgcn_permlane32_swap(u, u, false, false);
    return __builtin_bit_cast(float, (unsigned)b[0]) + __builtin_bit_cast(float, (unsigned)b[1]);
}
struct AttnJob {
    const bf16_t* Q; const bf16_t* K; const bf16_t* K2; const bf16_t* Vf; const float* krstd; const float* bias; const bf16_t* gate; bf16_t* O;
    int ldq, ldk, ldk2, ldg, ldo, k0, k1, qpos0, nq, tbw, ldv; float m0, l0;
    const float* qgain2; int qpos;
    const float* qgain;
};
template <int DK, bool LDSRC>
__device__ __forceinline__ void attn_tile(const bf16x8 (&qf)[2][DK / 32], f32x4 (&o)[8][2], float (&mrun)[2], float (&lrun)[2],
                                          const bf16_t* Kg, int ldk, const bf16_t* K2g, int ldk2, const bf16_t* Vblk, int vdt, int vlane, const float* rsg, const float* biasg,
                                          LAS const unsigned char* slot, LAS const float* tbl, int brel, bool half, bool has_rs, bool has_bias, int lane) {
    constexpr int NDS = DK / 32;
    const int r = lane & 15, g = lane >> 4;
    f32x4 s[2][2];
#pragma unroll
    for (int kt = 0; kt < 2; ++kt) {
        bf16x8 kf[NDS];
        if constexpr (LDSRC) {
#pragma unroll
            for (int ds = 0; ds < 4; ++ds) kf[ds] = *(LAS const bf16x8*)(slot + (((kt * 16 + ds * 4 + g) * 16 + r) << 4));
            if constexpr (DK == 192) {
#pragma unroll
                for (int d2 = 0; d2 < 2; ++d2) kf[4 + d2] = *(LAS const bf16x8*)(slot + 16384 + ((kt * 128 + (d2 * 4 + g) * 16 + r) << 4));
            }
        } else {
            const int krow = 8 * (r >> 2) + 4 * kt + (r & 3);
            const bf16_t* kp = Kg + (size_t)krow * ldk + g * 8;
#pragma unroll
            for (int ds = 0; ds < 4; ++ds) kf[ds] = *(const bf16x8*)(kp + ds * 32);
            if constexpr (DK == 192) { const bf16_t* kp2 = K2g + (size_t)krow * ldk2 + g * 8; kf[4] = *(const bf16x8*)kp2; kf[5] = *(const bf16x8*)(kp2 + 32); }
        }
#pragma unroll
        for (int qg = 0; qg < 2; ++qg) { f32x4 a = (f32x4){0.f, 0.f, 0.f, 0.f};
#pragma unroll
            for (int ds = 0; ds < NDS; ++ds) a = __builtin_amdgcn_mfma_f32_16x16x32_bf16(kf[ds], qf[qg][ds], a, 0, 0, 0);
            s[kt][qg] = a; }
        if constexpr (DK == 192 && !LDSRC) {
            float ssq = 0.f;
#pragma unroll
            for (int ds = 0; ds < NDS; ++ds) { float f[8]; unpack8(__builtin_bit_cast(u32x4, kf[ds]), f); ssq += sumsq8(f); }
            ssq = gsum4(ssq);
            const float rk = rsqrtf(ssq * (1.0f / 192.0f) + EPS);
            f32x4 rs; rs[0] = __shfl(rk, 4 * g); rs[1] = __shfl(rk, 4 * g + 1); rs[2] = __shfl(rk, 4 * g + 2); rs[3] = __shfl(rk, 4 * g + 3);
            s[kt][0] *= rs; s[kt][1] *= rs;
        }
    }
    if (has_rs && !(DK == 192 && !LDSRC)) {
#pragma unroll
        for (int kt = 0; kt < 2; ++kt) {
            f32x4 rs;
            if constexpr (LDSRC) rs = *(LAS const f32x4*)(slot + 20480 + ((8 * g + 4 * kt) << 2));
            else rs = (f32x4){rsg[8 * g + 4 * kt], rsg[8 * g + 4 * kt + 1], rsg[8 * g + 4 * kt + 2], rsg[8 * g + 4 * kt + 3]};
            s[kt][0] *= rs; s[kt][1] *= rs;
        }
    }
    if (has_bias) {
#pragma unroll
        for (int kt = 0; kt < 2; ++kt)
#pragma unroll
            for (int qg = 0; qg < 2; ++qg)
#pragma unroll
                for (int j = 0; j < 4; ++j) { const int idx = brel + qg * 16 + r - (8 * g + 4 * kt + j);
                    if constexpr (LDSRC) s[kt][qg][j] += tbl[idx]; else s[kt][qg][j] += biasg[idx]; }
    }
    if (half && g >= 2) { s[0][0] = (f32x4){-1e30f, -1e30f, -1e30f, -1e30f}; s[0][1] = s[0][0]; s[1][0] = s[0][0]; s[1][1] = s[0][0]; }
    bf16x8 pf[2]; float alpha[2];
#pragma unroll
    for (int qg = 0; qg < 2; ++qg) {
        float mx = fmaxf(fmaxf(fmaxf(s[0][qg][0], s[0][qg][1]), fmaxf(s[0][qg][2], s[0][qg][3])), fmaxf(fmaxf(s[1][qg][0], s[1][qg][1]), fmaxf(s[1][qg][2], s[1][qg][3])));
        mx = gmax4(mx);
        const float mn = fmaxf(mrun[qg], mx);
        alpha[qg] = fexp2(mrun[qg] - mn); mrun[qg] = mn;
        float p[8];
#pragma unroll
        for (int j = 0; j < 4; ++j) { p[j] = fexp2(s[0][qg][j] - mn); p[4 + j] = fexp2(s[1][qg][j] - mn); }
        lrun[qg] = lrun[qg] * alpha[qg] + ((p[0] + p[1]) + (p[2] + p[3])) + ((p[4] + p[5]) + (p[6] + p[7]));
        const u32x4 pk = pack8(p); pf[qg] = __builtin_bit_cast(bf16x8, pk);
    }
#pragma unroll
    for (int dt = 0; dt < 8; ++dt) {
        bf16x8 vf;
        if constexpr (LDSRC) vf = *(LAS const bf16x8*)(slot + 8192 + ((dt * 64 + lane) << 4)); else vf = *(const bf16x8*)(Vblk + (size_t)dt * vdt + vlane);
#pragma unroll
        for (int qg = 0; qg < 2; ++qg) { f32x4 a = o[dt][qg] * alpha[qg]; o[dt][qg] = __builtin_amdgcn_mfma_f32_16x16x32_bf16(vf, pf[qg], a, 0, 0, 0); }
    }
}
__device__ __forceinline__ void qnorm_frags(bf16x8 (&qf)[2][4], const float* gain, int lane) {
    const int g = lane >> 4;
#pragma unroll
    for (int qg = 0; qg < 2; ++qg) {
        float f[4][8]; float ss = 0.f;
#pragma unroll
        for (int ds = 0; ds < 4; ++ds) { unpack8(__builtin_bit_cast(u32x4, qf[qg][ds]), f[ds]); ss += sumsq8(f[ds]); }
        ss = gsum4(ss);
        const float rstd = rsqrtf(ss * (1.0f / 128.0f) + EPS) * (0.08838834764831845f * LOG2E);
#pragma unroll
        for (int ds = 0; ds < 4; ++ds) { const float* gp = gain + ds * 32 + g * 8;
#pragma unroll
            for (int e = 0; e < 8; ++e) f[ds][e] = f[ds][e] * rstd * gp[e];
            qf[qg][ds] = __builtin_bit_cast(bf16x8, pack8(f[ds])); }
    }
}
__device__ __forceinline__ void rope_cs(int pos, int i, float& cs, float& sn) {
    const float inv = fexp2(-(float)i * (13.287712379549449f / 32.0f));
    const float rev = (float)pos * inv * 0.15915494309189535f; const float fr = rev - rintf(rev);
    cs = __builtin_amdgcn_cosf(fr); sn = __builtin_amdgcn_sinf(fr);
}
__device__ __forceinline__ void qnorm_frags192(bf16x8 (&qf)[2][6], const float* gq, const float* gk, int pos0, int lane) {
    const int r = lane & 15, g = lane >> 4;
#pragma unroll
    for (int qg = 0; qg < 2; ++qg) {
        float f[6][8]; float ss = 0.f;
#pragma unroll
        for (int ds = 0; ds < 6; ++ds) unpack8(__builtin_bit_cast(u32x4, qf[qg][ds]), f[ds]);
        const int pos = pos0 + qg * 16 + r;
#pragma unroll
        for (int e = 0; e < 8; ++e) { float cs, sn; rope_cs(pos, g * 8 + e, cs, sn); const float x1 = f[4][e], x2 = f[5][e]; f[4][e] = x1 * cs - x2 * sn; f[5][e] = x1 * sn + x2 * cs; }
#pragma unroll
        for (int ds = 0; ds < 6; ++ds) ss += sumsq8(f[ds]);
        ss = gsum4(ss);
        const float rstd = rsqrtf(ss * (1.0f / 192.0f) + EPS) * (0.07216878364870322f * LOG2E);
#pragma unroll
        for (int ds = 0; ds < 6; ++ds) { const int d0 = ds * 32 + g * 8;
#pragma unroll
            for (int e = 0; e < 8; ++e) f[ds][e] = f[ds][e] * rstd * gq[d0 + e] * gk[d0 + e];
            qf[qg][ds] = __builtin_bit_cast(bf16x8, pack8(f[ds])); }
    }
}
template <int DK> __device__ __forceinline__ void attn_tile64(const bf16x8 (&qf)[2][DK / 32], f32x4 (&o)[8][2], float (&mrun)[2], float (&lrun)[2],
                                            LAS const unsigned char* slotA, LAS const unsigned char* slotB, LAS const float* tbl, int brel, bool has_bias, int lane) {
    const int r = lane & 15, g = lane >> 4;
    f32x4 s[4][2];
#pragma unroll
    for (int k4 = 0; k4 < 4; ++k4) {
        LAS const unsigned char* slot = (k4 < 2) ? slotA : slotB; const int kt = k4 & 1;
        bf16x8 kf[DK / 32];
#pragma unroll
        for (int ds = 0; ds < 4; ++ds) kf[ds] = *(LAS const bf16x8*)(slot + (((kt * 16 + ds * 4 + g) * 16 + r) << 4));
        if constexpr (DK == 192) {
#pragma unroll
            for (int d2 = 0; d2 < 2; ++d2) kf[4 + d2] = *(LAS const bf16x8*)(slot + 16384 + ((kt * 128 + (d2 * 4 + g) * 16 + r) << 4));
        }
#pragma unroll
        for (int qg = 0; qg < 2; ++qg) { f32x4 a = (f32x4){0.f, 0.f, 0.f, 0.f};
#pragma unroll
            for (int ds = 0; ds < DK / 32; ++ds) a = __builtin_amdgcn_mfma_f32_16x16x32_bf16(kf[ds], qf[qg][ds], a, 0, 0, 0);
            s[k4][qg] = a; }
        if constexpr (DK == 192) { const f32x4 rs = *(LAS const f32x4*)(slot + 20480 + ((8 * g + 4 * kt) << 2)); s[k4][0] *= rs; s[k4][1] *= rs; }
    }
    if (has_bias) {
#pragma unroll
        for (int k4 = 0; k4 < 4; ++k4)
#pragma unroll
            for (int qg = 0; qg < 2; ++qg)
#pragma unroll
                for (int j = 0; j < 4; ++j) s[k4][qg][j] += tbl[brel + qg * 16 + r - (32 * (k4 >> 1) + 8 * g + 4 * (k4 & 1) + j)];
    }
    bf16x8 pf[2][2]; float alpha[2];
#pragma unroll
    for (int qg = 0; qg < 2; ++qg) {
        float mx = -1e30f;
#pragma unroll
        for (int k4 = 0; k4 < 4; ++k4) mx = fmaxf(mx, fmaxf(fmaxf(s[k4][qg][0], s[k4][qg][1]), fmaxf(s[k4][qg][2], s[k4][qg][3])));
        mx = gmax4(mx);
        const float mn = fmaxf(mrun[qg], mx);
        alpha[qg] = fexp2(mrun[qg] - mn); mrun[qg] = mn;
        float sum = 0.f;
#pragma unroll
        for (int t = 0; t < 2; ++t) { float p[8];
#pragma unroll
            for (int j = 0; j < 4; ++j) { p[j] = fexp2(s[2 * t][qg][j] - mn); p[4 + j] = fexp2(s[2 * t + 1][qg][j] - mn); }
            sum += ((p[0] + p[1]) + (p[2] + p[3])) + ((p[4] + p[5]) + (p[6] + p[7]));
            const u32x4 pk = pack8(p); pf[t][qg] = __builtin_bit_cast(bf16x8, pk); }
        lrun[qg] = lrun[qg] * alpha[qg] + sum;
    }
#pragma unroll
    for (int dt = 0; dt < 8; ++dt) {
        const bf16x8 v0 = *(LAS const bf16x8*)(slotA + 8192 + ((dt * 64 + lane) << 4)), v1 = *(LAS const bf16x8*)(slotB + 8192 + ((dt * 64 + lane) << 4));
#pragma unroll
        for (int qg = 0; qg < 2; ++qg) { f32x4 a = o[dt][qg] * alpha[qg]; a = __builtin_amdgcn_mfma_f32_16x16x32_bf16(v0, pf[0][qg], a, 0, 0, 0); o[dt][qg] = __builtin_amdgcn_mfma_f32_16x16x32_bf16(v1, pf[1][qg], a, 0, 0, 0); }
    }
}
__device__ __forceinline__ void attn_store(const f32x4 (&o)[8][2], const float (&inv)[2], const bf16_t* gate, int ldg, bf16_t* O, int ldo, int nq, int lane) {
    const int r = lane & 15, g = lane >> 4;
#pragma unroll
    for (int qg = 0; qg < 2; ++qg) {
        const int row = qg * 16 + r;
        if (row < nq) {
            const bf16_t* gp = gate + (size_t)row * ldg + 4 * g; bf16_t* op = O + (size_t)row * ldo + 4 * g;
#pragma unroll
            for (int dt = 0; dt < 8; ++dt) {
                const u32x2 gv = *(const u32x2*)(gp + dt * 16);
                float gt[4] = {bflo(gv.x), bfhi(gv.x), bflo(gv.y), bfhi(gv.y)}, ov[4];
#pragma unroll
                for (int j = 0; j < 4; ++j) { const float sg = gt[j] / (1.0f + __expf(-gt[j])); ov[j] = o[dt][qg][j] * inv[qg] * sg; }
                *(u32x2*)(op + dt * 16) = (u32x2){cvt_pk_bf16(ov[0], ov[1]), cvt_pk_bf16(ov[2], ov[3])};
            }
        }
    }
}

typedef const __attribute__((address_space(4))) KP* KPP;
typedef const float* cfp_t; typedef const __attribute__((address_space(4))) cfp_t* cfp_as4p;
struct PView { cfp_as4p in; float* out; unsigned char* ws; };
struct Ctx {
    PView p; LAS unsigned char* lds; int tid, lane, wid, G, bx, gw, NW;
    __device__ __forceinline__ bf16_t* wsb(size_t off) const { return (bf16_t*)(p.ws + off); }
    __device__ __forceinline__ float* wsf(size_t off) const { return (float*)(p.ws + off); }
    __device__ __forceinline__ LAS bf16_t* wlds() const { return (LAS bf16_t*)(lds + wid * 16384); }
};

__device__ __forceinline__ void norm_row_2048(const float* x, bf16_t* xn, float* ycopy, int lane, const float* part = nullptr) {
    f32x4 v[8]; float ss = 0.f;
#pragma unroll
    for (int i = 0; i < 8; ++i) v[i] = *(const f32x4*)(x + i * 256 + lane * 4);
    if (part) {
        for (int ks = 0; ks < 8; ++ks)
#pragma unroll
            for (int i = 0; i < 8; ++i) v[i] += *(const f32x4*)(part + (size_t)ks * 128 * 2048 + i * 256 + lane * 4);
    }
#pragma unroll
    for (int i = 0; i < 8; ++i) ss += v[i][0] * v[i][0] + v[i][1] * v[i][1] + v[i][2] * v[i][2] + v[i][3] * v[i][3];
    ss = gsum<64>(ss);
    const float rstd = rsqrtf(ss * (1.0f / 2048.0f) + EPS);
#pragma unroll
    for (int i = 0; i < 8; ++i) {
        if (ycopy) *(f32x4*)(ycopy + i * 256 + lane * 4) = v[i];
        *(u32x2*)(xn + i * 256 + lane * 4) = (u32x2){cvt_pk_bf16(v[i][0] * rstd, v[i][1] * rstd), cvt_pk_bf16(v[i][2] * rstd, v[i][3] * rstd)};
    }
}

__device__ __forceinline__ void norm_row_2048_bf16(const bf16_t* x, bf16_t* xn, int lane) {
    u32x4 u[4]; float f[4][8]; float ss = 0.f;
#pragma unroll
    for (int i = 0; i < 4; ++i) u[i] = *(const u32x4*)(x + i * 512 + lane * 8);
#pragma unroll
    for (int i = 0; i < 4; ++i) { unpack8(u[i], f[i]); ss += sumsq8(f[i]); }
    ss = gsum<64>(ss);
    const float rstd = rsqrtf(ss * (1.0f / 2048.0f) + EPS);
#pragma unroll
    for (int i = 0; i < 4; ++i) {
#pragma unroll
        for (int e = 0; e < 8; ++e) f[i][e] *= rstd;
        *(u32x4*)(xn + i * 512 + lane * 8) = pack8(f[i]); }
}

__device__ __forceinline__ void nphase(const Ctx& c, int l) {
    const int kind = l % 3, j = l / 3;
    bf16_t* XN = c.wsb(WS_XN);
    for (int row = c.gw; row < MT; row += c.NW) {
        if (row < NR) {
            if (row < NP) { if (l == 0) norm_row_2048(c.p.in[0] + (size_t)row * DM, XN + (size_t)row * DM, nullptr, c.lane);
                else norm_row_2048_bf16((l == 3 ? c.wsb(WS_DYN + 200 * MiB) : (const bf16_t*)c.p.out) + (size_t)row * DM, XN + (size_t)row * DM, c.lane); }
            else norm_row_2048((l <= 1) ? c.p.in[1] + (size_t)(row - NP) * DM : c.p.out + (size_t)row * DM, XN + (size_t)row * DM, (l == 0) ? nullptr : c.p.out + (size_t)row * DM, c.lane,
                               (l == 0) ? nullptr : c.wsf(WS_PART) + (size_t)(row - NP) * DM);
        } else {
#pragma unroll
            for (int i = 0; i < 4; ++i) *(u32x4*)(XN + (size_t)row * DM + i * 512 + c.lane * 8) = (u32x4){0u, 0u, 0u, 0u};
        }
    }
    const int nin = (kind == 0) ? 5120 : (kind == 1 ? 3392 : 7168);
    const float* win = (kind == 0) ? c.p.in[18] + (size_t)j * 2048 * 5120 : (kind == 1 ? c.p.in[22] : c.p.in[29]);
    const float* gn = c.p.in[12] + l * 2048;
    const int t_in = 32 * (nin / 64), t_out = 32 * 32, t_qb = (kind == 1) ? 8 * 36 : 0, t_kvb = (kind == 1) ? 4 * 48 : 0;
    const int ttot = t_in + t_out + t_qb + t_kvb;
    LAS bf16_t* T = c.wlds();
    for (int t = c.gw; t < ttot; t += c.NW) {
        if (t < t_in) {
            const int kt = t % 32, ntile = t / 32; int n0 = ntile * 64, nd = n0;
            if (kind == 1) { if (n0 >= 1344) nd = n0 - 1344 + 1280; else if (n0 >= 832) nd = n0 - 832 + 768; else if (n0 >= 768) nd = n0 - 768 + 3328; }
            wtrans_tile(win, nin, kt * 64, n0, gn, c.wsb(WS_WIN) + (size_t)nd * 2048 + kt * 64, 2048, T, c.lane);
        } else if (t < t_in + t_out) {
            const int u = t - t_in, kt = u % 32, n0 = (u / 32) * 64;
            wtrans_tile(c.p.in[13] + (size_t)l * 2048 * 2048, 2048, kt * 64, n0, nullptr, c.wsb(WS_WOUT) + (size_t)n0 * 2048 + kt * 64, 2048, T, c.lane);
        } else if (t < t_in + t_out + t_qb) {
            const int u = t - t_in - t_out, kt = u % 8, n0 = (u / 8) * 64;
            wtrans_tile(c.p.in[24], 2304, kt * 64, n0, c.p.in[23], c.wsb(WS_WQB) + (size_t)n0 * 512 + kt * 64, 512, T, c.lane);
        } else {
            const int u = t - t_in - t_out - t_qb, kt = u % 4, n0 = (u / 4) * 64;
            const int h = n0 / 256, tt = (n0 % 256) / 128, d0 = n0 % 128;
            wtrans_tile(c.p.in[26], 3072, kt * 64, n0, nullptr, c.wsb(tt ? WS_WV : WS_WK) + (size_t)(h * 128 + d0) * 256 + kt * 64, 256, T, c.lane);
        }
    }
}

__device__ __forceinline__ void conv_rows(const Ctx& c, const float* src, size_t nelem, int W, int R, int R2, bf16_t* dst) {
    for (size_t e0 = (size_t)c.gw * 2048 + c.lane * 8; e0 < nelem; e0 += (size_t)c.NW * 2048) {
        float f[4][8];
#pragma unroll
        for (int q = 0; q < 4; ++q) load8(src + e0 + q * 512, f[q]);
#pragma unroll
        for (int q = 0; q < 4; ++q) { const size_t e = e0 + q * 512; const size_t row = e / W; const int col = (int)(e % W); const size_t bb = row / R; const int r = (int)(row % R);
            *(u32x4*)(dst + ((size_t)bb * R2 + r) * W + col) = pack8(f[q]); }
    }
}

__device__ __forceinline__ void prologue(const Ctx& c) {
    const PView& p = c.p;
    conv_rows(c, p.in[3], (size_t)2 * 8 * 128 * 512, 512, 128, 160, c.wsb(WS_KDA));
    conv_rows(c, p.in[7], (size_t)8 * 512 * 1536, 1536, 512, 544, c.wsb(WS_KDC));
    conv_rows(c, p.in[9], (size_t)4 * 8 * 256 * 512, 512, 256, 256, c.wsb(WS_KCMEM));
    conv_rows(c, p.in[5], (size_t)8 * 4096 * 256, 256, 4096, KVB, c.wsb(WS_CKVD));
    conv_rows(c, p.in[6], (size_t)8 * 4096 * 64, 64, 4096, KVB, c.wsb(WS_KRD));
    LAS bf16_t* Sx = c.wlds();
    for (int t = c.gw; t < 2 * 8 * 4 * 4; t += c.NW) { const int kb = t % 4, h = (t / 4) % 4, b = (t / 16) % 8, j = t / 128;
        vrelayout(p.in[4] + ((size_t)((j * 8 + b) * 128 + kb * 32) * 4 + h) * 128, 512, 32, c.wsb(WS_VFDA) + j * VFDA_L + (size_t)((b * 4 + h) * 5 + kb) * 4096, nullptr, 0, Sx, c.lane); }
    for (int t = c.gw; t < 8 * 12 * 16; t += c.NW) { const int kb = t % 16, h = (t / 16) % 12, b = t / 192;
        vrelayout(p.in[8] + ((size_t)(b * 512 + kb * 32) * 12 + h) * 128, 1536, 32, c.wsb(WS_VFDC) + (size_t)((b * 12 + h) * 17 + kb) * 4096, nullptr, 0, Sx, c.lane); }
    for (int t = c.gw; t < 4 * 8 * 4 * 8; t += c.NW) { const int kb = t % 8, h = (t / 8) % 4, lb = t / 32;
        vrelayout(p.in[10] + ((size_t)(lb * 256 + kb * 32) * 4 + h) * 128, 512, 32, c.wsb(WS_VFCMEM) + (size_t)((lb * 4 + h) * 8 + kb) * 4096, nullptr, 0, Sx, c.lane); }
    float* TBA = c.wsf(WS_TB); float* TBC = TBA + 12 * 256;
    for (int e = c.bx * 512 + c.tid; e < 12 * 256 + 12 * 640; e += c.G * 512) {
        if (e < 12 * 256) { const int h = e / 256, rel = (e % 256) - 64; const int n = rel < 0 ? -rel : rel;
            const int large = 8 + (n >= 12) + (n >= 16) + (n >= 23) + (n >= 32) + (n >= 46) + (n >= 64) + (n >= 91);
            const int bucket = (rel < 0 ? 16 : 0) + (n < 8 ? n : large);
            TBA[e] = p.in[11][bucket * 12 + h] * LOG2E;
        } else { const int u = e - 12 * 256, h = u / 640, rel = (u % 640) - 64; const int cl = (rel < -128 ? -128 : (rel > 128 ? 128 : rel)) + 128;
            TBC[u] = p.in[32][h * 257 + cl] * LOG2E; }
    }
    for (int row = c.gw; row < 2048; row += c.NW) norm_row_2048(p.in[2] + (size_t)row * DM, c.wsb(WS_DYN + DY_MEMN) + (size_t)row * DM, nullptr, c.lane);
    for (int t = c.gw; t < 4 * 32 * 16; t += c.NW) { const int kt = t % 32, nt = (t / 32) % 16, l = t / 512;
        wtrans_tile(p.in[15] + (size_t)l * 2048 * 1024, 1024, kt * 64, nt * 64, p.in[14] + l * 2048, c.wsb(WS_DYN + DY_WMEM) + (size_t)(l * 1024 + nt * 64) * 2048 + kt * 64, 2048, Sx, c.lane); }
    nphase(c, 0);
}

__device__ __forceinline__ void head_norm(float (&f)[8], const float* g, float scale, int lane) {
    const float ss = gsum<16>(sumsq8(f));
    const float rstd = rsqrtf(ss * (1.0f / 128.0f) + EPS) * scale;
    const float* gp = g + (lane & 15) * 8;
#pragma unroll
    for (int e = 0; e < 8; ++e) f[e] = f[e] * rstd * gp[e];
}

__device__ __forceinline__ void memp(const Ctx& c) {
    const bf16_t* ZM = c.wsb(WS_DYN + DY_ZM);
    for (int t = c.gw; t < 4 * 2048; t += c.NW) { const int l = t / 2048, row = t % 2048;
        float f[8]; load8(ZM + (size_t)row * 4096 + l * 1024 + c.lane * 8, f);
        head_norm(f, c.p.in[17] + l * 128, 1.0f, c.lane);
        store8f(c.p.out + O_MK + ((size_t)l * 2048 + row) * 512 + c.lane * 8, f);
        *(u32x4*)(c.wsb(WS_KMEM) + ((size_t)l * 2048 + row) * 512 + c.lane * 8) = pack8(f);
    }
    LAS bf16_t* Sx = c.wlds();
    for (int t = c.gw; t < 4 * 8 * 4 * 8; t += c.NW) { const int kb = t % 8, h = (t / 8) % 4, b = (t / 32) % 8, l = t / 256;
        vrelayout(ZM + (size_t)(b * 256 + kb * 32) * 4096 + l * 1024 + 512 + h * 128, 4096, 32, c.wsb(WS_VFMEM) + (size_t)(((l * 8 + b) * 4 + h) * 8 + kb) * 4096,
                  c.p.out + O_MV + ((size_t)(l * 8 + b) * 256 + kb * 32) * 512 + h * 128, 512, Sx, c.lane); }
}

struct LayerAC { int ldz, ko, vo, xo, go, nkh, keep, past, kdrows, nblk; size_t okp, ovp, oks, ovs; bf16_t* Z; bf16_t* Kdec; bf16_t* Vfdec; bf16_t* Vf; const float* gq; const float* gk; const float* gxq; const float* tb; int tbw; const float* sink; };
__device__ __forceinline__ LayerAC layer_ac(const Ctx& c, int l) {
    LayerAC L; const int kind = l % 3, j = l / 3;
    L.Z = c.wsb(WS_DYN); L.gxq = c.p.in[16] + l * 128;
    if (kind == 0) { L.ldz = 5120; L.ko = 1536; L.vo = 2048; L.xo = 2560; L.go = 3072; L.nkh = 4; L.keep = 128; L.past = 128; L.kdrows = 160; L.nblk = 5;
        L.okp = O_AKP; L.ovp = O_AVP; L.oks = O_AKS; L.ovs = O_AVS;
        L.Kdec = c.wsb(WS_KDA) + j * KDA_L; L.Vfdec = c.wsb(WS_VFDA) + j * VFDA_L; L.Vf = c.wsb(WS_DYN + DY_VFA); L.gq = c.p.in[19] + j * 128; L.gk = c.p.in[20] + j * 128;
        L.tb = c.wsf(WS_TB); L.tbw = 256; L.sink = c.p.in[21] + j * 12;
    } else { L.ldz = 7168; L.ko = 1536; L.vo = 3072; L.xo = 4608; L.go = 5120; L.nkh = 12; L.keep = 512; L.past = 512; L.kdrows = 544; L.nblk = 17;
        L.okp = O_CKP; L.ovp = O_CVP; L.oks = O_CKS; L.ovs = O_CVS;
        L.Kdec = c.wsb(WS_KDC); L.Vfdec = c.wsb(WS_VFDC); L.Vf = c.wsb(WS_DYN + DY_VFC); L.gq = c.p.in[30]; L.gk = c.p.in[31];
        L.tb = c.wsf(WS_TB) + 12 * 256; L.tbw = 640; L.sink = nullptr; }
    return L;
}
constexpr float QS128 = 0.08838834764831845f * LOG2E;
constexpr float QS192 = 0.07216878364870322f * LOG2E;

__device__ __forceinline__ void post_ac(const Ctx& c, int l) {
    const LayerAC L = layer_ac(c, l); const int j = l / 3, nk = L.nkh * 128;
    const int nkc = L.nkh / 4;
    for (int row = c.gw; row < NR; row += c.NW) {
        bf16_t* zr = L.Z + (size_t)row * L.ldz;
        const bool samp = row >= NP; const int b = samp ? (row - NP) / DEC : row / SEQ, s = samp ? (row - NP) % DEC : row % SEQ;
        u32x4 vk[3];
#pragma unroll
        for (int ch = 0; ch < 3; ++ch) vk[ch] = (ch < nkc) ? *(const u32x4*)(zr + L.ko + ch * 512 + c.lane * 8) : (u32x4){0u, 0u, 0u, 0u};
#pragma unroll
        for (int ch = 0; ch < 3; ++ch) if (ch < nkc) { const int col = ch * 512 + c.lane * 8; float f[8]; unpack8(vk[ch], f); head_norm(f, L.gk, 1.0f, c.lane);
            const u32x4 pk = pack8(f); *(u32x4*)(zr + L.ko + col) = pk;
            if (samp) { store8f(c.p.out + L.oks + ((size_t)(j * 8 + b) * DEC + s) * nk + col, f); *(u32x4*)(L.Kdec + ((size_t)b * L.kdrows + L.past + s) * nk + col) = pk; }
            else if (s >= SEQ - L.keep) store8f(c.p.out + L.okp + ((size_t)(j * 8 + b) * L.keep + (s - (SEQ - L.keep))) * nk + col, f); }
    }
    LAS bf16_t* Sx = c.wlds();
    const int nvp = 8 * L.nkh * 64;
    for (int t = c.gw; t < nvp + 8 * L.nkh; t += c.NW) {
        if (t < nvp) { const int kb = t % 64, bh = t / 64, b = bh / L.nkh, h = bh % L.nkh;
            float* fo = (kb * 32 >= SEQ - L.keep) ? c.p.out + L.ovp + ((size_t)(j * 8 + b) * L.keep + (kb * 32 - (SEQ - L.keep))) * nk + h * 128 : nullptr;
            vrelayout(L.Z + (size_t)(b * SEQ + kb * 32) * L.ldz + L.vo + h * 128, L.ldz, 32, L.Vf + (size_t)(bh * 64 + kb) * 4096, fo, nk, Sx, c.lane);
        } else { const int bh = t - nvp, b = bh / L.nkh, h = bh % L.nkh;
            vrelayout(L.Z + (size_t)(NP + b * DEC) * L.ldz + L.vo + h * 128, L.ldz, 16, L.Vfdec + (size_t)(bh * L.nblk + L.past / 32) * 4096,
                      c.p.out + L.ovs + ((size_t)(j * 8 + b) * DEC) * nk + h * 128, nk, Sx, c.lane); }
    }
}

constexpr int ZB_LD = 3584, ZB_CKV = 512, ZB_XQ = 768, ZB_G = 1280, ZB_KR = 3328;
__device__ __forceinline__ void post1_b(const Ctx& c, int l) {
    bf16_t* Z = c.wsb(WS_DYN + DY_ZB);
    for (int row = c.gw; row < NR; row += c.NW) {
        bf16_t* zr = Z + (size_t)row * ZB_LD;
        const bool samp = row >= NP; const int b = samp ? (row - NP) / DEC : row / SEQ, s = samp ? (row - NP) % DEC : row % SEQ;
        { float f[8]; bf16_t* pp = zr + c.lane * 8; load8(pp, f); const float rstd = rsqrtf(gsum<64>(sumsq8(f)) * (1.0f / 512.0f) + EPS);
#pragma unroll
            for (int e = 0; e < 8; ++e) f[e] *= rstd;
            *(u32x4*)pp = pack8(f); }
        {
            float f[8]; bf16_t* pp = zr + 512 + c.lane * 8; load8(pp, f); const float sq = sumsq8(f);
            const float s32 = gsum<32>(sq), s16 = gsum<16>(sq);
            if (c.lane < 32) { const float rstd = rsqrtf(s32 * (1.0f / 256.0f) + EPS); const float* gp = c.p.in[25] + c.lane * 8;
#pragma unroll
                for (int e = 0; e < 8; ++e) f[e] = f[e] * rstd * gp[e];
                const u32x4 pk = pack8(f); *(u32x4*)pp = pk;
                if (samp) { store8f(c.p.out + O_BCS + ((size_t)b * DEC + s) * 256 + c.lane * 8, f); *(u32x4*)(c.wsb(WS_CKVD) + ((size_t)b * KVB + PAST + s) * 256 + c.lane * 8) = pk; }
                else store8f(c.p.out + O_BCP + (size_t)row * 256 + c.lane * 8, f);
            }
            (void)s16;
        }
        if (c.lane >= 32) {
            const int i = c.lane - 32; const float x1 = bf1(zr[ZB_KR + i]), x2 = bf1(zr[ZB_KR + 32 + i]);
            float cs, sn; rope_cs(samp ? PAST + s : s, i, cs, sn);
            const float y1 = x1 * cs - x2 * sn, y2 = x1 * sn + x2 * cs;
            float* fo = samp ? c.p.out + O_BRS + ((size_t)b * DEC + s) * 64 : c.p.out + O_BRP + (size_t)row * 64;
            fo[i] = y1; fo[32 + i] = y2;
            bf16_t* kr = samp ? c.wsb(WS_KRD) + ((size_t)b * KVB + PAST + s) * 64 : c.wsb(WS_DYN + DY_KRP) + (size_t)row * 64;
            kr[i] = (bf16_t)f2bf(y1); kr[32 + i] = (bf16_t)f2bf(y2);
        }
    }
}
__device__ __forceinline__ bf16_t* vfdec_base(const Ctx& c, int b) { return b < 5 ? (bf16_t*)(c.p.ws + WS_DYN + (size_t)b * VFDEC_B) : (bf16_t*)((unsigned char*)(c.p.out + O_CKP) + (size_t)(b - 5) * VFDEC_B); }
__device__ __forceinline__ void post2_b(const Ctx& c, int round) {
    const bf16_t* Kb = c.wsb(WS_DYN + (round ? DY_KDEC : DY_KP));
    const bf16_t* KR = round ? c.wsb(WS_KRD) : c.wsb(WS_DYN + DY_KRP); float* RS = round ? c.wsf(WS_RSTDD) : c.wsf(WS_DYN + DY_RSTDP);
    const int nrows = round ? NB * KVB : NP, kpb = round ? KVB : SEQ, rld = round ? RSD_LD : SEQ;
    for (int row = c.gw; row < nrows; row += c.NW) {
        float kr = 0.f; if (c.lane < 8) { float f[8]; load8(KR + (size_t)row * 64 + c.lane * 8, f); kr = sumsq8(f); }
        kr = gsum<8>(kr); kr = __shfl(kr, 0);
        u32x4 vk[3];
#pragma unroll
        for (int ch = 0; ch < 3; ++ch) vk[ch] = *(const u32x4*)(Kb + (size_t)row * 1536 + ch * 512 + c.lane * 8);
#pragma unroll
        for (int ch = 0; ch < 3; ++ch) { float f[8]; unpack8(vk[ch], f); const float ss = gsum<16>(sumsq8(f)) + kr;
            if ((c.lane & 15) == 0) RS[((size_t)(row / kpb) * 12 + ch * 4 + (c.lane >> 4)) * rld + (row % kpb)] = rsqrtf(ss * (1.0f / 192.0f) + EPS); }
    }
}

#define MKCTXN(c) Ctx c; { int tid_ = threadIdx.x, bx_ = blockIdx.x, G_ = gridDim.x; KPP kp_ = (KPP)__builtin_amdgcn_kernarg_segment_ptr(); \
            asm volatile("" : "+s"(kp_), "+v"(tid_), "+s"(bx_), "+s"(G_)); \
            extern __shared__ __attribute__((aligned(16))) unsigned char smem[]; \
            c.lds = (LAS unsigned char*)smem; c.tid = tid_; c.lane = tid_ & 63; c.wid = __builtin_amdgcn_readfirstlane(tid_ >> 6); \
            c.G = G_; c.bx = bx_; c.gw = bx_ * 8 + c.wid; c.NW = G_ * 8; c.p.in = kp_->in; c.p.out = kp_->out; c.p.ws = kp_->ws; }
#define MKCTX MKCTXN(c)
struct SJob { const bf16_t* K; const bf16_t* K2; const bf16_t* Vf; const float* rs; int ldk, ldk2, K0, K1, ldv; };
constexpr int AT_NS = 5, AT_SLOT = 21504, AT_TBL = AT_NS * AT_SLOT;
template <int DK> __device__ __forceinline__ void attn_shared(const Ctx& c, const SJob& S, const AttnJob& J) {
    constexpr int NDS = DK / 32;
    LAS unsigned char* lds = c.lds; const int T = c.tid, lane = c.lane, w = c.wid, r = lane & 15, g = lane >> 4;
    LAS float* tbl = (LAS float*)(lds + AT_TBL + w * 2560);
    if (J.bias) { for (int i = lane; i < J.tbw; i += 64) tbl[i] = J.bias[i]; }
    bf16x8 qf[2][NDS];
#pragma unroll
    for (int qg = 0; qg < 2; ++qg)
#pragma unroll
        for (int ds = 0; ds < NDS; ++ds) qf[qg][ds] = *(const bf16x8*)(J.Q + (size_t)(qg * 16 + r) * J.ldq + ds * 32 + g * 8);
    if constexpr (DK == 128) { if (J.qgain) qnorm_frags(qf, J.qgain, lane); } else { qnorm_frags192(qf, J.qgain, J.qgain2, J.qpos, lane); }
    f32x4 o[8][2];
#pragma unroll
    for (int dt = 0; dt < 8; ++dt) { o[dt][0] = (f32x4){0.f, 0.f, 0.f, 0.f}; o[dt][1] = (f32x4){0.f, 0.f, 0.f, 0.f}; }
    float mrun[2] = {J.m0, J.m0}, lrun[2]; lrun[0] = lrun[1] = (g == 0) ? J.l0 : 0.f;
    asm volatile("s_waitcnt vmcnt(0)" ::: "memory"); wave_lds_fence();
    const int ntiles = (S.K1 - S.K0) >> 5;
    const bf16_t* ksrc = S.K + (size_t)(S.K0 + 8 * ((T & 15) >> 2) + 4 * (T >> 8) + (T & 3)) * S.ldk + ((T >> 4) & 15) * 8;
    const bf16_t* vsrc = S.ldv ? S.Vf + (size_t)(16 * (T >> 6) + (T & 15)) * S.ldv + S.K0 + 8 * ((T >> 4) & 3) : S.Vf + (size_t)(S.K0 >> 5) * 4096 + T * 8;
    const size_t vstep = S.ldv ? 32 : 4096;
    const bf16_t* xsrc = nullptr; size_t xstep = 0; unsigned xdst = 0;
    if constexpr (DK == 192) {
        if (w == 4) { xsrc = (const bf16_t*)(S.rs + S.K0) + lane * 8; xstep = 64; xdst = 20480; }
        else { const int p2 = T & 255; xsrc = S.K2 + (size_t)(S.K0 + 8 * ((p2 & 15) >> 2) + 4 * (p2 >> 7) + (p2 & 3)) * S.ldk2 + ((p2 >> 4) & 7) * 8; xstep = (size_t)32 * S.ldk2; xdst = 16384 + (w & 3) * 1024; }
    }
    const size_t kstep = (size_t)32 * S.ldk;
#define AT_ISSUE(tile, sl) do { const int _t = (tile) < ntiles ? (tile) : ntiles - 1; const unsigned _so = (unsigned)(sl) * AT_SLOT; \
        __builtin_amdgcn_global_load_lds((const unsigned*)(ksrc + _t * kstep), (LAS unsigned*)(lds + _so + w * 1024), 16, 0, 0); \
        __builtin_amdgcn_global_load_lds((const unsigned*)(vsrc + _t * vstep), (LAS unsigned*)(lds + _so + 8192 + w * 1024), 16, 0, 0); \
        if constexpr (DK == 192) __builtin_amdgcn_global_load_lds((const unsigned*)(xsrc + _t * xstep), (LAS unsigned*)(lds + _so + xdst), 16, 0, 0); } while (0)
    if constexpr (true) {
        const int npairs = ntiles >> 1;
        AT_ISSUE(0, 0); AT_ISSUE(1, 1);
        for (int jp = 0; jp < npairs; ++jp) {
            asm volatile("s_waitcnt vmcnt(0)" ::: "memory");
            __builtin_amdgcn_s_barrier(); asm volatile("" ::: "memory");
            const int ps = (jp & 1) * 2, pn = 2 - ps;
            if (jp + 1 < npairs) { AT_ISSUE(2 * jp + 2, pn); AT_ISSUE(2 * jp + 3, pn + 1); }
            const int kb = S.K0 + jp * 64;
            if (kb >= J.k0 && kb < J.k1)
                attn_tile64<DK>(qf, o, mrun, lrun, lds + ps * AT_SLOT, lds + (ps + 1) * AT_SLOT, tbl, J.qpos0 - kb + 64, J.bias != nullptr, lane);
        }
        asm volatile("s_waitcnt vmcnt(0)" ::: "memory");
        __builtin_amdgcn_s_barrier(); asm volatile("" ::: "memory");
    } else {
#pragma unroll
    for (int i = 0; i < AT_NS - 1; ++i) AT_ISSUE(i, i);
    int sl = 0;
    for (int i = 0; i < ntiles; ++i) {
        if constexpr (DK == 192) asm volatile("s_waitcnt vmcnt(9)" ::: "memory"); else asm volatile("s_waitcnt vmcnt(6)" ::: "memory");
        __builtin_amdgcn_s_barrier(); asm volatile("" ::: "memory");
        const int sn = (sl == 0) ? AT_NS - 1 : sl - 1;
        AT_ISSUE(i + AT_NS - 1, sn);
        const int kb = S.K0 + i * 32;
        if (kb >= J.k0 && kb < J.k1)
            attn_tile<DK, true>(qf, o, mrun, lrun, nullptr, 0, nullptr, 0, nullptr, 0, 0, nullptr, nullptr, lds + sl * AT_SLOT, tbl, J.qpos0 - kb + 64, false, DK == 192, J.bias != nullptr, lane);
        sl = (sl == AT_NS - 1) ? 0 : sl + 1;
    }
    asm volatile("s_waitcnt vmcnt(0)" ::: "memory");
    __builtin_amdgcn_s_barrier(); asm volatile("" ::: "memory");
    }
#undef AT_ISSUE
    float inv[2];
#pragma unroll
    for (int qg = 0; qg < 2; ++qg) { float l = lrun[qg]; l = gsum4(l); inv[qg] = 1.0f / l; }
    attn_store(o, inv, J.gate, J.ldg, J.O, J.ldo, 32, lane);
}
template <int DK> __device__ __forceinline__ void attn_split(const Ctx& c, const AttnJob& J) {
    constexpr int NDS = DK / 32;
    const int lane = c.lane, w = c.wid, r = lane & 15, g = lane >> 4;
    bf16x8 qf[2][NDS];
#pragma unroll
    for (int qg = 0; qg < 2; ++qg)
#pragma unroll
        for (int ds = 0; ds < NDS; ++ds) qf[qg][ds] = *(const bf16x8*)(J.Q + (size_t)(qg * 16 + r) * J.ldq + ds * 32 + g * 8);
    if constexpr (DK == 128) { if (J.qgain) qnorm_frags(qf, J.qgain, lane); } else { qnorm_frags192(qf, J.qgain, J.qgain2, J.qpos, lane); }
    f32x4 o1[8];
#pragma unroll
    for (int dt = 0; dt < 8; ++dt) o1[dt] = (f32x4){0.f, 0.f, 0.f, 0.f};
    float m1 = (w == 0) ? J.m0 : -1e30f, l1 = (w == 0 && g == 0) ? J.l0 : 0.f;
    bf16x8 kc[2][NDS], kn[2][NDS];
#define DK_LOADK(dst, kb_) do { _Pragma("unroll") for (int kt = 0; kt < 2; ++kt) { const int krow = (kb_) + 8 * (r >> 2) + 4 * kt + (r & 3); \
        const bf16_t* kp = J.K + (size_t)krow * J.ldk + g * 8; _Pragma("unroll") for (int ds = 0; ds < 4; ++ds) dst[kt][ds] = *(const bf16x8*)(kp + ds * 32); \
        if constexpr (DK == 192) { const bf16_t* kp2 = J.K2 + (size_t)krow * J.ldk2 + g * 8; dst[kt][4] = *(const bf16x8*)kp2; dst[kt][5] = *(const bf16x8*)(kp2 + 32); } } } while (0)
    int kb = J.k0 + 32 * w;
    if (kb < J.k1) DK_LOADK(kc, kb);
    for (; kb < J.k1; kb += 256) {
        const bool more = kb + 256 < J.k1;
        if (more) DK_LOADK(kn, kb + 256);
        const bf16_t* vb = J.ldv ? J.Vf + kb + (size_t)r * J.ldv + 8 * g : J.Vf + (size_t)(kb >> 5) * 4096 + lane * 8; const size_t vdt = J.ldv ? (size_t)16 * J.ldv : 512;
        bf16x8 vf[8];
#pragma unroll
        for (int dt = 0; dt < 8; ++dt) vf[dt] = *(const bf16x8*)(vb + dt * vdt);
        f32x4 s[2];
#pragma unroll
        for (int kt = 0; kt < 2; ++kt) { f32x4 acc0 = (f32x4){0.f, 0.f, 0.f, 0.f};
#pragma unroll
            for (int ds = 0; ds < NDS; ++ds) acc0 = __builtin_amdgcn_mfma_f32_16x16x32_bf16(kc[kt][ds], qf[0][ds], acc0, 0, 0, 0);
            if constexpr (DK == 192) {
                float ssq = 0.f;
#pragma unroll
                for (int ds = 0; ds < NDS; ++ds) { float f[8]; unpack8(__builtin_bit_cast(u32x4, kc[kt][ds]), f); ssq += sumsq8(f); }
                ssq = gsum4(ssq);
                const float rk = rsqrtf(ssq * (1.0f / 192.0f) + EPS);
                f32x4 rs; rs[0] = __shfl(rk, 4 * g); rs[1] = __shfl(rk, 4 * g + 1); rs[2] = __shfl(rk, 4 * g + 2); rs[3] = __shfl(rk, 4 * g + 3);
                acc0 *= rs; }
            s[kt] = acc0; }
        if (J.bias) {
#pragma unroll
            for (int kt = 0; kt < 2; ++kt)
#pragma unroll
                for (int j = 0; j < 4; ++j) s[kt][j] += J.bias[J.qpos0 - kb + 64 + r - (8 * g + 4 * kt + j)];
        }
        if (kb + 16 >= J.k1 && g >= 2) { s[0] = (f32x4){-1e30f, -1e30f, -1e30f, -1e30f}; s[1] = s[0]; }
        float mx = fmaxf(fmaxf(fmaxf(s[0][0], s[0][1]), fmaxf(s[0][2], s[0][3])), fmaxf(fmaxf(s[1][0], s[1][1]), fmaxf(s[1][2], s[1][3])));
        mx = gmax4(mx);
        const float mn = fmaxf(m1, mx), alpha = fexp2(m1 - mn); m1 = mn;
        float p[8];
#pragma unroll
        for (int j = 0; j < 4; ++j) { p[j] = fexp2(s[0][j] - mn); p[4 + j] = fexp2(s[1][j] - mn); }
        l1 = l1 * alpha + ((p[0] + p[1]) + (p[2] + p[3])) + ((p[4] + p[5]) + (p[6] + p[7]));
        const u32x4 pk = pack8(p); const bf16x8 pf = __builtin_bit_cast(bf16x8, pk);
#pragma unroll
        for (int dt = 0; dt < 8; ++dt) { f32x4 a2 = o1[dt] * alpha; o1[dt] = __builtin_amdgcn_mfma_f32_16x16x32_bf16(vf[dt], pf, a2, 0, 0, 0); }
        if (more) {
#pragma unroll
            for (int kt = 0; kt < 2; ++kt)
#pragma unroll
                for (int ds = 0; ds < NDS; ++ds) kc[kt][ds] = kn[kt][ds]; }
    }
#undef DK_LOADK
    float l = gsum4(l1);
    LAS unsigned char* my = c.lds + w * 16384;
#pragma unroll
    for (int dt = 0; dt < 8; ++dt) *(LAS f32x4*)(my + ((dt * 64 + lane) << 4)) = o1[dt];
    *(LAS float*)(my + 8192 + lane * 4) = m1; *(LAS float*)(my + 8448 + lane * 4) = l;
    __syncthreads();
    float mv[8], M = -1e30f;
#pragma unroll
    for (int v = 0; v < 8; ++v) { mv[v] = *(LAS const float*)(c.lds + v * 16384 + 8192 + lane * 4); M = fmaxf(M, mv[v]); }
    float L = 0.f; f32x4 acc = (f32x4){0.f, 0.f, 0.f, 0.f};
#pragma unroll
    for (int v = 0; v < 8; ++v) { const float sc = fexp2(mv[v] - M); L += sc * *(LAS const float*)(c.lds + v * 16384 + 8448 + lane * 4);
        acc += *(LAS const f32x4*)(c.lds + v * 16384 + ((w * 64 + lane) << 4)) * sc; }
    if (r < J.nq) {
        const float inv = 1.0f / L;
        const u32x2 gv = *(const u32x2*)(J.gate + (size_t)r * J.ldg + w * 16 + 4 * g);
        float gt[4] = {bflo(gv.x), bfhi(gv.x), bflo(gv.y), bfhi(gv.y)}, ov[4];
#pragma unroll
        for (int j = 0; j < 4; ++j) { const float sg = gt[j] / (1.0f + __expf(-gt[j])); ov[j] = acc[j] * inv * sg; }
        *(u32x2*)(J.O + (size_t)r * J.ldo + w * 16 + 4 * g) = (u32x2){cvt_pk_bf16(ov[0], ov[1]), cvt_pk_bf16(ov[2], ov[3])};
    }
    __syncthreads();
}

__device__ __forceinline__ void attn_phase(const Ctx& c, int l, int round) {
    const int kind = l % 3;
    bf16_t* O = c.wsb(WS_XN);
    const bool r1 = (kind == 1 && round == 1);
    const int n_dec = (kind == 1) ? (r1 ? 96 : 0) : 96, n_xd = r1 ? 0 : 32, n_mix = r1 ? 0 : 768, n_xp = r1 ? 0 : 256;
    const int ntot = n_dec + n_xd + n_mix + n_xp;
    LayerAC L = layer_ac(c, kind == 1 ? 0 : l);
    const bf16_t* Z = (kind == 1) ? c.wsb(WS_DYN + DY_ZB) : L.Z; const int ldz = (kind == 1) ? ZB_LD : L.ldz, xo = (kind == 1) ? ZB_XQ : L.xo, go = (kind == 1) ? ZB_G : L.go;
    const int w = c.wid;
    unsigned* qctr = (unsigned*)(c.p.ws + WS_BAR) + 3520 + ((l * 2 + round) * 8 + (c.bx & 7)) * 4;
    volatile LAS unsigned* qslot = (volatile LAS unsigned*)(c.lds + 131072 + 64);
    const bool useq = (c.G % 8) == 0;
    if (c.tid == 0) qslot[0] = useq ? atomicAdd(qctr, 1u) : 0u;
    for (int it = 0;; ++it) {
        __syncthreads();
        const int kq = __builtin_amdgcn_readfirstlane((int)qslot[it & 1]);
        const int u0 = useq ? (int)(c.bx & 7) + 8 * kq : c.bx + it * c.G;
        if (u0 >= ntot) break;
        if (useq && c.tid == 0) qslot[(it + 1) & 1] = atomicAdd(qctr, 1u);
        int u = u0; AttnJob J; J.K2 = nullptr; J.ldk2 = 0; J.krstd = nullptr; J.bias = nullptr; J.tbw = 0; J.qpos0 = 0; J.m0 = -1e30f; J.l0 = 0.f; J.ldg = ldz; J.ldo = DM; J.nq = 32; J.k0 = 0; J.ldv = 0;
        J.qgain = (kind == 1) ? c.p.in[27] : L.gq; J.qgain2 = c.p.in[28]; J.qpos = 0;
        bool dk192 = false;
        if (u < n_dec + n_xd) {
            J.nq = DEC;
            if (u < n_dec) {
                const int b = u / 12, h = u % 12; const size_t row0 = NP + b * DEC;
                J.gate = Z + row0 * ldz + go + h * 128; J.O = O + row0 * DM + h * 128;
                if (kind == 1) {
                    dk192 = true;
                    J.Q = c.wsb(WS_DYN + DY_QB) + row0 * 2304 + h * 192; J.ldq = 2304; J.K = c.wsb(WS_DYN + DY_KDEC) + (size_t)b * KVB * 1536 + h * 128; J.ldk = 1536;
                    J.K2 = c.wsb(WS_KRD) + (size_t)b * KVB * 64; J.ldk2 = 64; J.Vf = c.wsb(WS_DYN + DY_VDEC) + (size_t)h * 128 * KVB_ROWS + (size_t)b * KVB; J.ldv = KVB_ROWS; J.krstd = c.wsf(WS_RSTDD) + (size_t)(b * 12 + h) * RSD_LD;
                    J.k1 = KVB; J.qpos = PAST;
                } else {
                    const int kvh = (kind == 0) ? h / 3 : h, nk = L.nkh * 128;
                    J.Q = Z + row0 * ldz + h * 128; J.ldq = ldz; J.K = L.Kdec + (size_t)b * L.kdrows * nk + kvh * 128; J.ldk = nk; J.Vf = L.Vfdec + (size_t)((b * L.nkh + kvh) * L.nblk) * 4096;
                    J.bias = L.tb + h * L.tbw; J.qpos0 = L.past; J.k1 = L.past + DEC;
                    if (L.sink) { J.m0 = L.sink[h] * LOG2E; J.l0 = 1.f; }
                }
            } else {
                u -= n_dec; const int b = u / 4, h = u % 4; const size_t row0 = NP + b * DEC; J.qgain = c.p.in[16] + l * 128;
                J.Q = Z + row0 * ldz + xo + h * 128; J.ldq = ldz; J.K = c.wsb(WS_KCMEM) + ((size_t)(l * 8 + b) * 256) * 512 + h * 128; J.ldk = 512; J.Vf = c.wsb(WS_VFCMEM) + (size_t)(((l * 8 + b) * 4 + h) * 8) * 4096;
                J.k1 = 256; J.gate = Z + row0 * ldz + go + 1536 + h * 128; J.O = O + row0 * DM + 1536 + h * 128;
            }
            if (dk192) { MKCTXN(cc); attn_split<192>(cc, J); } else { MKCTXN(cc); attn_split<128>(cc, J); }
            continue;
        }
        u -= n_dec + n_xd;
        SJob S; S.K2 = nullptr; S.ldk2 = 0; S.rs = nullptr; S.ldv = 0;
        if (u < n_mix) {
            int bh, qb8;
            if (kind == 1) {
                const int li = u;
                qb8 = 7 - li / 96; bh = li % 96;
            } else { const int k = u >> 8, x = u & 7, y = (u & 255) >> 3; bh = k * 32 + x * 4 + (y >> 3); qb8 = y & 7; }
            const int b = bh / 12, h = bh % 12, qb = qb8 * 8 + w, ch = qb >> 1; const size_t row0 = (size_t)b * SEQ + qb * 32;
            J.gate = Z + row0 * ldz + go + h * 128; J.O = O + row0 * DM + h * 128; J.k1 = (ch + 1) * 64; S.K1 = (qb8 * 4 + 4) * 64;
            if (kind == 1) {
                dk192 = true;
                J.Q = c.wsb(WS_DYN + DY_QB) + row0 * 2304 + h * 192; J.ldq = 2304; S.K = c.wsb(WS_DYN + DY_KP) + (size_t)b * SEQ * 1536 + h * 128; S.ldk = 1536;
                S.K2 = c.wsb(WS_DYN + DY_KRP) + (size_t)b * SEQ * 64; S.ldk2 = 64; S.Vf = c.wsb(WS_DYN + DY_VP) + (size_t)h * 128 * NP + (size_t)b * SEQ; S.ldv = NP; S.rs = c.wsf(WS_DYN + DY_RSTDP) + (size_t)bh * SEQ;
                S.K0 = 0; J.qpos = qb * 32;
            } else {
                const int kvh = (kind == 0) ? h / 3 : h, nprev = (kind == 0) ? 2 : 8, c0 = qb8 * 4;
                J.Q = Z + row0 * ldz + h * 128; J.ldq = ldz; S.K = Z + (size_t)b * SEQ * ldz + L.ko + kvh * 128; S.ldk = ldz; S.Vf = L.Vf + (size_t)((b * L.nkh + kvh) * 64) * 4096;
                J.bias = L.tb + h * L.tbw; J.tbw = L.tbw; J.qpos0 = qb * 32; J.k0 = (ch > nprev ? ch - nprev : 0) * 64; S.K0 = (c0 > nprev ? c0 - nprev : 0) * 64;
                if (L.sink) { J.m0 = L.sink[h] * LOG2E; J.l0 = 1.f; }
            }
        } else {
            J.qgain = c.p.in[16] + l * 128;
            u -= n_mix; const int x = u & 7, y = u >> 3, qb8 = y & 7, bh = x * 4 + (y >> 3), b = bh / 4, h = bh % 4, qb = qb8 * 8 + w; const size_t row0 = (size_t)b * SEQ + qb * 32;
            J.Q = Z + row0 * ldz + xo + h * 128; J.ldq = ldz; S.K = c.wsb(WS_KMEM) + ((size_t)(l * 8 + b) * 256) * 512 + h * 128; S.ldk = 512; S.Vf = c.wsb(WS_VFMEM) + (size_t)(((l * 8 + b) * 4 + h) * 8) * 4096;
            S.K0 = 0; S.K1 = 256; J.k1 = 256; J.gate = Z + row0 * ldz + go + 1536 + h * 128; J.O = O + row0 * DM + 1536 + h * 128;
        }
        if (dk192) { MKCTXN(cc); attn_shared<192>(cc, S, J); } else { MKCTXN(cc); attn_shared<128>(cc, S, J); }
    }
}

#define XB_TMO      128
#define XB_XCNT(j)  (256  + 64 * (j))
#define XB_XSUB(j)  (1280 + 64 * (j))
#define XB_XGEN(j)  (2304 + 64 * (j))
#define XB_TOP      3328
#define XB_TOPGEN   3392
#define XCD_BAR_WORDS 3456
#define XB_SPIN_CAP (1u << 22)
__device__ __forceinline__ unsigned xb_ld(unsigned* p)              { return __hip_atomic_load(p, __ATOMIC_RELAXED, __HIP_MEMORY_SCOPE_AGENT); }
__device__ __forceinline__ unsigned xb_add(unsigned* p, unsigned v) { return __hip_atomic_fetch_add(p, v, __ATOMIC_RELAXED, __HIP_MEMORY_SCOPE_AGENT); }
__device__ __forceinline__ unsigned xb_xcc_id() { return (unsigned)__builtin_amdgcn_s_getreg((3 << 11) | 20) & 0xFu; }
#define XB_SPIN(cond, bar) do { unsigned _sp = 0; while (cond) { __builtin_amdgcn_s_sleep(1); \
    if ((++_sp & 255u) == 0u) { if (xb_ld(&(bar)[XB_TMO])) break; if (_sp > XB_SPIN_CAP) { atomicAdd(&(bar)[XB_TMO], 1u); break; } } } } while (0)
struct XcdBarrier { unsigned* bar; unsigned x; volatile LAS unsigned* st; };
__device__ __forceinline__ XcdBarrier xcd_barrier_post(unsigned* bar, volatile LAS unsigned* st) {
    XcdBarrier b; b.bar = bar; b.x = xb_xcc_id(); b.st = st;
    if (threadIdx.x == 0) (void)xb_add(&bar[XB_XCNT(b.x)], 1u);
    return b;
}
__device__ __forceinline__ void xcd_barrier_complete(unsigned* bar, unsigned x, unsigned& nloc, unsigned& nx) {
    const unsigned G = gridDim.x * gridDim.y * gridDim.z;
    unsigned sum, cnt, mine, sp = 0u;
    for (;;) {
        sum = 0u; cnt = 0u; mine = 0u;
#pragma unroll
        for (unsigned j = 0; j < 16; ++j) { const unsigned c = xb_ld(&bar[XB_XCNT(j)]); sum += c; cnt += (c > 0u) ? 1u : 0u; mine = (j == x) ? c : mine; }
        if (sum == G) break;
        __builtin_amdgcn_s_sleep(1);
        if ((++sp & 255u) == 0u) { if (xb_ld(&bar[XB_TMO])) break; if (sp > XB_SPIN_CAP) { atomicAdd(&bar[XB_TMO], 1u); break; } }
    }
    nloc = mine > 0u ? mine : 1u; nx = cnt > 0u ? cnt : 1u;
}
__device__ __forceinline__ void xcd_barrier(const XcdBarrier& b) {
    asm volatile("s_waitcnt vmcnt(0)" ::: "memory");
#ifdef PARANOID_BAR
    __builtin_amdgcn_fence(__ATOMIC_RELEASE, "agent");
    asm volatile("s_waitcnt vmcnt(0)" ::: "memory");
#endif
    __syncthreads();
    if (threadIdx.x == 0) {
        unsigned* bar = b.bar;
        __builtin_amdgcn_s_waitcnt(0);
        unsigned nloc = b.st[0], nx = b.st[1];
        if (nloc == 0u) { xcd_barrier_complete(bar, b.x, nloc, nx); b.st[0] = nloc; b.st[1] = nx; }
        const unsigned old = xb_add(&bar[XB_XSUB(b.x)], 1u);
        const unsigned gen = old / nloc;
        if (old + 1u == (gen + 1u) * nloc) {
            __builtin_amdgcn_fence(__ATOMIC_RELEASE, "agent");
            asm volatile("s_waitcnt vmcnt(0)" ::: "memory");
            const unsigned og = xb_add(&bar[XB_TOP], 1u);
            const unsigned tg = og / nx;
            if (og + 1u == (tg + 1u) * nx) xb_add(&bar[XB_TOPGEN], 1u);
            else XB_SPIN(xb_ld(&bar[XB_TOPGEN]) == tg, bar);
            __builtin_amdgcn_fence(__ATOMIC_ACQUIRE, "agent");
            xb_add(&bar[XB_XGEN(b.x)], 1u);
            asm volatile("s_waitcnt vmcnt(0)" ::: "memory");
        } else {
            XB_SPIN(xb_ld(&bar[XB_XGEN(b.x)]) == gen, bar);
            __builtin_amdgcn_fence(__ATOMIC_ACQUIRE, "agent");
            asm volatile("s_waitcnt vmcnt(0)" ::: "memory");
        }
    }
    __syncthreads();
#ifdef PARANOID_BAR
    __builtin_amdgcn_fence(__ATOMIC_ACQUIRE, "agent");
    asm volatile("s_waitcnt vmcnt(0)" ::: "memory");
    __syncthreads();
#endif
}

enum { GL_MEM = 0, GL_IN = 1, GL_OUT = 2, GL_B1 = 3, GL_B2 = 4, GL_MEMIN = 5 };
__device__ __forceinline__ bool get_gemm(const Ctx& c, int list, int l, int i, GemmDesc& d) {
    const int kind = l % 3;
    d.epi = 0; d.mvalid = 0; d.R = nullptr; d.rbf = 0; d.cbf = 0; d.sBm = 0; d.sCm = 0; d.rot = 0;
    if (list == GL_MEMIN) { if (i == 0) { list = GL_MEM; d.rot = 128; } else { list = GL_IN; --i; } }
    if (list == GL_MEM) { if (i) return false; d.A = c.wsb(WS_DYN + DY_MEMN); d.lda = 2048; d.Bt = c.wsb(WS_DYN + DY_WMEM); d.ldb = 2048; d.C = c.wsb(WS_DYN + DY_ZM); d.ldc = 4096; d.nM = 8; d.nN = 16; d.K = 2048; return true; }
    if (list == GL_IN) { if (i) return false; d.A = c.wsb(WS_XN); d.lda = 2048; d.Bt = c.wsb(WS_WIN); d.ldb = 2048; d.K = 2048; d.nM = 65;
        if (kind == 0) { d.C = c.wsb(WS_DYN); d.ldc = 5120; d.nN = 20; } else if (kind == 1) { d.C = c.wsb(WS_DYN + DY_ZB); d.ldc = ZB_LD; d.nN = 14; } else { d.C = c.wsb(WS_DYN); d.ldc = 7168; d.nN = 28; }
        return true; }
    if (list == GL_OUT) {
        if (i > 1) return false; d.Bt = c.wsb(WS_WOUT); d.ldb = 2048; d.lda = 2048; d.ldc = 2048; d.nN = 8;
        if (i == 0) { d.A = c.wsb(WS_XN); d.K = 2048; d.nM = 64; d.epi = 1; d.mvalid = NP; d.sAm = (size_t)256 * 2048 * 2;
            d.rbf = (l != 0); d.cbf = (l != 3);
            d.R = (l == 0) ? (const void*)c.p.in[0] : (l == 3 ? (const void*)c.wsb(WS_DYN + 200 * MiB) : (const void*)c.p.out);
            d.C = (l == 3) ? (void*)c.p.out : (l == 2 ? (void*)c.wsb(WS_DYN + 200 * MiB) : (void*)c.p.out); }
        else { d.A = c.wsb(WS_XN) + (size_t)NP * 2048; d.K = 256; d.nM = 8; d.C = c.wsf(WS_PART); d.epi = 3; d.sAm = 512; d.sBm = 512; d.sCm = (size_t)128 * 2048; }
        return true; }
    if (list == GL_B1) {
        if (i == 0) { d.A = c.wsb(WS_DYN + DY_ZB); d.lda = ZB_LD; d.Bt = c.wsb(WS_WQB); d.ldb = 512; d.K = 512; d.nM = 65; d.nN = 9; d.C = c.wsb(WS_DYN + DY_QB); d.ldc = 2304; return true; }
        if (i > 2) return false;
        d.K = 256;
        if (i == 1) { d.A = c.wsb(WS_DYN + DY_ZB) + ZB_CKV; d.lda = ZB_LD; d.Bt = c.wsb(WS_WK); d.ldb = 256; d.nM = 64; d.nN = 6; d.C = c.wsb(WS_DYN + DY_KP); d.ldc = 1536; }
        else { d.A = c.wsb(WS_WV); d.lda = 256; d.Bt = c.wsb(WS_DYN + DY_ZB) + ZB_CKV; d.ldb = ZB_LD; d.nM = 6; d.nN = 64; d.C = c.wsb(WS_DYN + DY_VP); d.ldc = NP; }
        return true;
    }
    if (i > 1) return false;
    d.K = 256;
    if (i == 0) { d.A = c.wsb(WS_CKVD); d.lda = 256; d.Bt = c.wsb(WS_WK); d.ldb = 256; d.nM = 129; d.nN = 6; d.C = c.wsb(WS_DYN + DY_KDEC); d.ldc = 1536; }
    else { d.A = c.wsb(WS_WV); d.lda = 256; d.Bt = c.wsb(WS_CKVD); d.ldb = 256; d.nM = 6; d.nN = 129; d.C = c.wsb(WS_DYN + DY_VDEC); d.ldc = KVB_ROWS; }
    return true;
}

enum { OP_PRO = 0, OP_NPH, OP_GEMM, OP_MEMP_GEMM, OP_POSTAC, OP_POST1B, OP_POST2B, OP_ATT, OP_FIN };
struct Step { unsigned char op, l, a; };
__device__ const Step PROG[] = {
    {OP_PRO, 0, 0},
    {OP_GEMM, 0, GL_MEMIN}, {OP_POSTAC, 0, 1}, {OP_ATT, 0, 0}, {OP_GEMM, 0, GL_OUT},
    {OP_NPH, 1, 0}, {OP_GEMM, 1, GL_IN}, {OP_POST1B, 1, 0}, {OP_GEMM, 1, GL_B1}, {OP_POST2B, 1, 0}, {OP_ATT, 1, 0}, {OP_GEMM, 1, GL_B2}, {OP_ATT, 1, 1}, {OP_GEMM, 1, GL_OUT},
    {OP_NPH, 2, 0}, {OP_GEMM, 2, GL_IN}, {OP_POSTAC, 2, 0}, {OP_ATT, 2, 0}, {OP_GEMM, 2, GL_OUT},
    {OP_NPH, 3, 0}, {OP_GEMM, 3, GL_IN}, {OP_POSTAC, 3, 0}, {OP_ATT, 3, 0}, {OP_GEMM, 3, GL_OUT}, {OP_FIN, 3, 0},
};
#ifndef ATT_REP
#define ATT_REP 1
#endif
#ifndef GEMM_REP
#define GEMM_REP 1
#endif
#ifndef NPH_REP
#define NPH_REP 1
#endif
#ifndef ATT_REP_STEP
#define ATT_REP_STEP -1
#endif
#ifndef NRUN
#define NRUN 99
#endif
constexpr int NSTEPS = (NRUN < (int)(sizeof(PROG) / sizeof(Step))) ? NRUN : (int)(sizeof(PROG) / sizeof(Step));

__global__ void __launch_bounds__(512, 2) fwd_megakernel(KP p) {
    extern __shared__ __attribute__((aligned(16))) unsigned char smem[];
    KPP kp0 = (KPP)__builtin_amdgcn_kernarg_segment_ptr();
    volatile LAS unsigned* st = (volatile LAS unsigned*)((LAS unsigned char*)smem + 131072);
    if (threadIdx.x < 16) st[threadIdx.x] = 0u;
    __syncthreads();
    const XcdBarrier bar = xcd_barrier_post((unsigned*)(kp0->ws + WS_BAR), st);
    for (int st = 0; st < NSTEPS; ++st) {
        const int op = PROG[st].op, l = PROG[st].l, a = PROG[st].a;
        if (op == OP_PRO) { MKCTX; prologue(c); }
        else if (op == OP_NPH) { MKCTX; for (int rep = 0; rep < NPH_REP; ++rep) nphase(c, l); }
        else if (op == OP_POSTAC) { if (a) { MKCTX; memp(c); } MKCTX; post_ac(c, l); }
        else if (op == OP_POST1B) { MKCTX; post1_b(c, l); }
        else if (op == OP_FIN) { MKCTX;
            for (int rr = c.gw; rr < NB * DEC; rr += c.NW) { float* y = c.p.out + (size_t)(NP + rr) * DM; const float* part = c.wsf(WS_PART) + (size_t)rr * DM;
                f32x4 v[8];
#pragma unroll
                for (int i = 0; i < 8; ++i) v[i] = *(const f32x4*)(y + i * 256 + c.lane * 4);
                for (int ks = 0; ks < 8; ++ks)
#pragma unroll
                    for (int i = 0; i < 8; ++i) v[i] += *(const f32x4*)(part + (size_t)ks * 128 * 2048 + i * 256 + c.lane * 4);
#pragma unroll
                for (int i = 0; i < 8; ++i) *(f32x4*)(y + i * 256 + c.lane * 4) = v[i]; } }
        else if (op == OP_POST2B) { MKCTX; post2_b(c, a); }
        else if (op == OP_ATT) { for (int rep = 0; rep < ((st == ATT_REP_STEP) ? 2 : ATT_REP); ++rep) { MKCTX; attn_phase(c, l, a); } }
        else {
            if (op == OP_MEMP_GEMM) { MKCTX; memp(c); __syncthreads(); }
            MKCTX;
            GemmDesc d;
            for (int rep = 0; rep < (a == GL_OUT ? 1 : GEMM_REP); ++rep)
            for (int i = 0; (d.sAm = 0, get_gemm(c, a, l, i, d)); ++i) { if (d.sAm == 0) d.sAm = (size_t)256 * d.lda * 2; pg8::StaticOrder S; S.init(d.nM, d.nN, c.G, (c.bx + c.G - d.rot) % c.G); pg8::gemm_phase(c.lds, d, S); }
        }
        if (st + 1 < NSTEPS) xcd_barrier(bar);
    }
    asm volatile("s_waitcnt vmcnt(0)" ::: "memory");
    __syncthreads();
    if (threadIdx.x == 0) { __builtin_amdgcn_fence(__ATOMIC_RELEASE, "agent"); asm volatile("s_waitcnt vmcnt(0)" ::: "memory"); }
}

extern "C" void kernel_launch(void* const* d_in, const int* in_sizes, int n_in, void* d_out, int out_size, void* d_ws, size_t ws_size, hipStream_t stream) {
    static int grid_blocks = 0;
    constexpr size_t kDynLds = 131072 + 256;
    if (grid_blocks == 0) {
        if (n_in != 33 || (size_t)out_size != O_END || ws_size < WS_NEED) { fprintf(stderr, "kernel_launch: unexpected shapes n_in %d out %d ws %zu (need %zu)\n", n_in, out_size, ws_size, (size_t)WS_NEED); grid_blocks = -1; return; }
        int dev = 0, cus = 0, per_cu = 0;
        hipGetDevice(&dev);
        hipDeviceGetAttribute(&cus, hipDeviceAttributeMultiprocessorCount, dev);
        hipFuncSetAttribute((const void*)fwd_megakernel, hipFuncAttributeMaxDynamicSharedMemorySize, (int)kDynLds);
        hipOccupancyMaxActiveBlocksPerMultiprocessor(&per_cu, (const void*)fwd_megakernel, 512, kDynLds);
        if (per_cu < 1) per_cu = 1;
        if (per_cu > 1) per_cu = 1;
        grid_blocks = cus * per_cu;
        (void)hipGetLastError();
    }
    if (grid_blocks < 0) return;
    if (hipMemsetAsync((char*)d_ws + WS_BAR, 0, 16384, stream) != hipSuccess) { fprintf(stderr, "kernel_launch: memset failed\n"); return; }
    KP p{};
    for (int i = 0; i < 33; ++i) p.in[i] = (const float*)d_in[i];
    p.out = (float*)d_out; p.ws = (unsigned char*)d_ws;
    void* args[] = {&p};
    hipError_t e = hipLaunchCooperativeKernel((const void*)fwd_megakernel, dim3(grid_blocks), dim3(512), args, kDynLds, stream);
    if (e != hipSuccess) fprintf(stderr, "cooperative launch failed: %s (grid %d)\n", hipGetErrorString(e), grid_blocks);
}
```

```cpp
#include <hip/hip_runtime.h>
#include <hip/hip_cooperative_groups.h>
#include <cstdio>
#include <cstdint>
namespace cg = cooperative_groups;

#define LAS __attribute__((address_space(3)))
typedef unsigned short bf16_t;
typedef short bf16x8 __attribute__((ext_vector_type(8)));
typedef float f32x4 __attribute__((ext_vector_type(4)));
typedef unsigned u32x4 __attribute__((ext_vector_type(4)));
typedef unsigned u32x2 __attribute__((ext_vector_type(2)));

constexpr int SEQ = 2048, NB = 8, DEC = 16, PAST = 4096, DM = 2048;
constexpr int NP = NB * SEQ;
constexpr int NR = NP + NB * DEC;
constexpr int MT = 16640;
constexpr int KVB = PAST + DEC;
constexpr int KVB_ROWS = 33024;
constexpr int RSD_LD = 4128;
constexpr float EPS = 1e-6f;
constexpr float LOG2E = 1.4426950408889634f;

constexpr size_t O_YP = 0, O_YS = 33554432, O_AKP = O_YS + 262144, O_AVP = O_AKP + 1048576, O_AKS = O_AVP + 1048576, O_AVS = O_AKS + 131072,
    O_BCP = O_AVS + 131072, O_BRP = O_BCP + 4194304, O_BCS = O_BRP + 1048576, O_BRS = O_BCS + 32768, O_CKP = O_BRS + 8192, O_CVP = O_CKP + 6291456,
    O_CKS = O_CVP + 6291456, O_CVS = O_CKS + 196608, O_MK = O_CVS + 196608, O_MV = O_MK + 4194304, O_END = O_MV + 4194304;

constexpr size_t MiB = 1u << 20;
constexpr size_t WS_WIN = 0, WS_WOUT = 28 * MiB, WS_WQB = 36 * MiB, WS_WK = WS_WQB + 2304 * 512 * 2, WS_WV = WS_WK + 1536 * 256 * 2;
constexpr size_t WS_XN = 40 * MiB;
constexpr size_t WS_KMEM = 105 * MiB, WS_VFMEM = 113 * MiB, WS_KCMEM = 121 * MiB, WS_VFCMEM = 129 * MiB;
constexpr size_t WS_KDA = 137 * MiB, WS_VFDA = 140 * MiB, WS_KDC = 143 * MiB, WS_VFDC = 156 * MiB, WS_CKVD = 169 * MiB, WS_KRD = 186 * MiB,
    WS_RSTDD = 191 * MiB, WS_TB = 193 * MiB, WS_BAR = 193 * MiB + 512 * 1024, WS_DYN = 194 * MiB;
constexpr size_t KDA_L = 8 * 160 * 512, VFDA_L = 8 * 4 * 5 * 4096;
constexpr size_t DY_MEMN = 200 * MiB, DY_ZM = 208 * MiB, DY_WMEM = 224 * MiB;
constexpr size_t DY_VFA = 164 * MiB, DY_VFC = 228 * MiB;
constexpr size_t DY_QB = 0, DY_ZB = 74 * MiB, DY_KP = 188 * MiB, DY_VP = 236 * MiB, DY_KRP = 286 * MiB, DY_RSTDP = 288 * MiB;
constexpr size_t DY_KDEC = 76 * MiB, DY_VDEC = 188 * MiB;
constexpr size_t VFDEC_B = (size_t)12 * 129 * 4096 * 2;
constexpr size_t WS_PART = WS_DYN + 290 * MiB;
constexpr size_t WS_NEED = WS_DYN + 298 * MiB;

struct KP { const float* in[33]; float* out; unsigned char* ws; };

__device__ __forceinline__ unsigned cvt_pk_bf16(float lo, float hi) { unsigned r; asm volatile("v_cvt_pk_bf16_f32 %0, %1, %2" : "=v"(r) : "v"(lo), "v"(hi)); return r; }
__device__ __forceinline__ unsigned f2bf(float f) { return cvt_pk_bf16(f, 0.f) & 0xffffu; }
__device__ __forceinline__ float bflo(unsigned u) { return __builtin_bit_cast(float, u << 16); }
__device__ __forceinline__ float bfhi(unsigned u) { return __builtin_bit_cast(float, u & 0xffff0000u); }
__device__ __forceinline__ float bf1(bf16_t u) { return __builtin_bit_cast(float, ((unsigned)u) << 16); }
__device__ __forceinline__ void unpack8(u32x4 u, float (&f)[8]) { f[0] = bflo(u.x); f[1] = bfhi(u.x); f[2] = bflo(u.y); f[3] = bfhi(u.y); f[4] = bflo(u.z); f[5] = bfhi(u.z); f[6] = bflo(u.w); f[7] = bfhi(u.w); }
__device__ __forceinline__ u32x4 pack8(const float (&f)[8]) { u32x4 r; r.x = cvt_pk_bf16(f[0], f[1]); r.y = cvt_pk_bf16(f[2], f[3]); r.z = cvt_pk_bf16(f[4], f[5]); r.w = cvt_pk_bf16(f[6], f[7]); return r; }
__device__ __forceinline__ void load8(const bf16_t* p, float (&f)[8]) { unpack8(*(const u32x4*)p, f); }
__device__ __forceinline__ void load8(const float* p, float (&f)[8]) { f32x4 a = *(const f32x4*)p, b = *(const f32x4*)(p + 4); f[0] = a[0]; f[1] = a[1]; f[2] = a[2]; f[3] = a[3]; f[4] = b[0]; f[5] = b[1]; f[6] = b[2]; f[7] = b[3]; }
__device__ __forceinline__ void store8f(float* p, const float (&f)[8]) { *(f32x4*)p = (f32x4){f[0], f[1], f[2], f[3]}; *(f32x4*)(p + 4) = (f32x4){f[4], f[5], f[6], f[7]}; }
template <int G> __device__ __forceinline__ float gsum(float v) {
#pragma unroll
    for (int o = 1; o < G; o <<= 1) v += __shfl_xor(v, o);
    return v;
}
__device__ __forceinline__ float sumsq8(const float (&f)[8]) { float s = 0.f;
#pragma unroll
    for (int e = 0; e < 8; ++e) s += f[e] * f[e];
    return s; }
__device__ __forceinline__ void wave_lds_fence() { asm volatile("s_waitcnt lgkmcnt(0)" ::: "memory"); __builtin_amdgcn_wave_barrier(); }
__device__ __forceinline__ float fexp2(float x) { return __builtin_amdgcn_exp2f(x); }

namespace pg8 {
constexpr int BM = 256, BK = 64, HALF = 128, HTB = HALF * BK * 2, NXCD = 8, WGM = 16;
__device__ __forceinline__ int lds_byte(int r, int c) { const int st = (r >> 4) * 2 + (c >> 5), rr = r & 15, cc = c & 31, ob = rr * 64 + cc * 2; return st * 1024 + (ob ^ (((ob >> 9) & 1) << 5)); }
__device__ __forceinline__ void stage_rc(int b, int& R, int& C) { const int st = b / 1024, sb = b % 1024, swz = sb ^ (((sb >> 9) & 1) << 5); R = (st >> 1) * 16 + swz / 64; C = (st & 1) * 32 + (swz % 64) / 2; }
__device__ __forceinline__ int perm32(int rho) { const int n = rho >> 4, i = rho & 15; return 8 * (i >> 2) + 4 * n + (i & 3); }
struct Unit { int pm, pn; };
struct GemmDesc { const bf16_t* A; const bf16_t* Bt; void* C; const void* R; int rbf, cbf;
  size_t sAm, sBm, sCm; int lda, ldb, ldc, nM, nN, K, epi, mvalid, rot; };
struct StaticOrder {
    int nM, nN, nwg, G, c;
    __device__ void init(int nM_, int nN_, int G_, int c_) { nM = nM_; nN = nN_; nwg = nM * nN; G = G_; c = c_; }
    __device__ bool next(int i, Unit& u) const {
        const long L = (long)i * G + c; if (L >= nwg) return false;
        int wgid = (int)L; { const int q = nwg / NXCD, r = nwg % NXCD, xcd = wgid % NXCD, off = wgid / NXCD; wgid = (xcd < r ? xcd * (q + 1) : r * (q + 1) + (xcd - r) * q) + off; }
        const int nig = WGM * nN, gid = wgid / nig, fm = gid * WGM, gsz = (nM - fm) < WGM ? (nM - fm) : WGM;
        u.pm = fm + ((wgid % nig) % gsz); u.pn = (wgid % nig) / gsz; return true;
    }
};
__device__ __forceinline__ void epilogue(const f32x4 (&acc)[2][2][4][2], const GemmDesc& g, const Unit& u, int wr, int wc, int fr, int fq) {
    const int row0 = u.pm * BM + wr * 64 + fr, col0 = u.pn * BM + wc * 32 + 8 * fq;
    if (g.epi == 0) {
        bf16_t* O = (bf16_t*)g.C;
#pragma unroll
        for (int ai = 0; ai < 2; ++ai)
#pragma unroll
            for (int m = 0; m < 4; ++m) { bf16_t* rowp = O + (size_t)(row0 + ai * HALF + m * 16) * g.ldc + col0;
#pragma unroll
                for (int bj = 0; bj < 2; ++bj) { const f32x4 v0 = acc[ai][bj][m][0], v1 = acc[ai][bj][m][1]; u32x4 w; w.x = cvt_pk_bf16(v0[0], v0[1]); w.y = cvt_pk_bf16(v0[2], v0[3]); w.z = cvt_pk_bf16(v1[0], v1[1]); w.w = cvt_pk_bf16(v1[2], v1[3]);
                    *(u32x4*)(rowp + bj * HALF) = w; } }
    } else if (g.epi == 1) {
#pragma unroll
        for (int ai = 0; ai < 2; ++ai)
#pragma unroll
            for (int m = 0; m < 4; ++m) { const int row = row0 + ai * HALF + m * 16; if (row < g.mvalid) { const size_t off = (size_t)row * g.ldc + col0;
#pragma unroll
                for (int bj = 0; bj < 2; ++bj) { f32x4 a, b;
                    if (g.rbf) { const u32x4 rv = *(const u32x4*)((const bf16_t*)g.R + off + bj * HALF); a = (f32x4){bflo(rv.x), bfhi(rv.x), bflo(rv.y), bfhi(rv.y)}; b = (f32x4){bflo(rv.z), bfhi(rv.z), bflo(rv.w), bfhi(rv.w)}; }
                    else { a = *(const f32x4*)((const float*)g.R + off + bj * HALF); b = *(const f32x4*)((const float*)g.R + off + bj * HALF + 4); }
                    a += acc[ai][bj][m][0]; b += acc[ai][bj][m][1];
                    if (g.cbf) { u32x4 w; w.x = cvt_pk_bf16(a[0], a[1]); w.y = cvt_pk_bf16(a[2], a[3]); w.z = cvt_pk_bf16(b[0], b[1]); w.w = cvt_pk_bf16(b[2], b[3]); *(u32x4*)((bf16_t*)g.C + off + bj * HALF) = w; }
                    else { *(f32x4*)((float*)g.C + off + bj * HALF) = a; *(f32x4*)((float*)g.C + off + bj * HALF + 4) = b; } } } }
    } else {
        float* O = (float*)g.C + (size_t)u.pm * g.sCm;
#pragma unroll
        for (int m = 0; m < 4; ++m) { float* rowp = O + (size_t)(wr * 64 + fr + m * 16) * g.ldc + col0;
#pragma unroll
            for (int bj = 0; bj < 2; ++bj) { *(f32x4*)(rowp + bj * HALF) = acc[0][bj][m][0]; *(f32x4*)(rowp + bj * HALF + 4) = acc[0][bj][m][1]; } }
    }
}
__device__ __forceinline__ void gemm_phase(LAS unsigned char* lds, const GemmDesc g, const StaticOrder& S) {
    const int tid = threadIdx.x, wid = __builtin_amdgcn_readfirstlane(tid >> 6), lane = tid & 63, wr = wid >> 2, wc = wid & 3, fr = lane & 15, fq = lane >> 4;
    const int K = g.K, nt = K / BK;
    unsigned voffA[2], voffB[2];
#pragma unroll
    for (int i = 0; i < 2; ++i) { int R, C; stage_rc(tid * 16 + i * 8192, R, C); const int Rb = (R & ~31) + perm32(R & 31);
        voffA[i] = (unsigned)(R * g.lda + C) * 2u; voffB[i] = (unsigned)(Rb * g.ldb + C) * 2u; }
    const size_t kstep = (size_t)(BK * 2);
    const size_t hstepA = (size_t)HALF * g.lda * 2, hstepB = (size_t)HALF * g.ldb * 2;
    const size_t tstepB = 2 * hstepB;
    const unsigned ldsw = (unsigned)wid * 1024u;
    const int aoff = lds_byte(wr * 64 + fr, fq * 8), boff = lds_byte(wc * 32 + fr, fq * 8);
#define PG8_SA(b, h) (((b) * 2 + (h)) * HTB)
#define PG8_SB(b, h) ((4 + (b) * 2 + (h)) * HTB)
#define PG8_STAGE(bufoff, gbase, voff) do { _Pragma("unroll") for (int _i = 0; _i < 2; ++_i) \
        __builtin_amdgcn_global_load_lds((const unsigned*)((const char*)(gbase) + (voff)[_i]), (LAS unsigned*)(lds + (bufoff) + ldsw + _i * 8192), 16, 0, 0); } while (0)
#define PG8_LDA(dst, b, h) do { _Pragma("unroll") for (int m = 0; m < 4; ++m) _Pragma("unroll") for (int k = 0; k < 2; ++k) dst[m][k] = *(const LAS bf16x8*)(lds + PG8_SA(b, h) + aoff + m * 2048 + k * 1024); } while (0)
#define PG8_LDB(dst, b, h) do { _Pragma("unroll") for (int n = 0; n < 2; ++n) _Pragma("unroll") for (int k = 0; k < 2; ++k) dst[n][k] = *(const LAS bf16x8*)(lds + PG8_SB(b, h) + boff + n * 2048 + k * 1024); } while (0)
#define PG8_MMA(ai, bj, At, Bt) do { __builtin_amdgcn_s_setprio(1); _Pragma("unroll") for (int m = 0; m < 4; ++m) _Pragma("unroll") for (int n = 0; n < 2; ++n) _Pragma("unroll") for (int k = 0; k < 2; ++k) \
        acc[ai][bj][m][n] = __builtin_amdgcn_mfma_f32_16x16x32_bf16(Bt[n][k], At[m][k], acc[ai][bj][m][n], 0, 0, 0); __builtin_amdgcn_s_setprio(0); } while (0)
#define PG8_WAIT_V(n) asm volatile("s_waitcnt vmcnt(" #n ")" ::: "memory")
#define PG8_WAIT_L(n) asm volatile("s_waitcnt lgkmcnt(" #n ")" ::: "memory")
#define PG8_BAR __builtin_amdgcn_s_barrier()
#define PG8_SCHED __builtin_amdgcn_sched_barrier(0)
    Unit cur, nxt; int ui = 0;
    if (!S.next(0, cur)) return;
    f32x4 acc[2][2][4][2];
#pragma unroll
    for (int a = 0; a < 2; ++a)
#pragma unroll
        for (int b = 0; b < 2; ++b)
#pragma unroll
            for (int m = 0; m < 4; ++m)
#pragma unroll
                for (int n = 0; n < 2; ++n) acc[a][b][m][n] = (f32x4){0.f, 0.f, 0.f, 0.f};
    bf16x8 At[4][2], B0[2][2], B1[2][2];
    const char* cA = (const char*)g.A + (size_t)cur.pm * g.sAm; const char* cB = (const char*)g.Bt + (size_t)cur.pn * tstepB + (size_t)cur.pm * g.sBm;
    PG8_STAGE(PG8_SB(0, 0), cB, voffB); PG8_STAGE(PG8_SB(0, 1), cB + hstepB, voffB); PG8_STAGE(PG8_SA(0, 0), cA, voffA); PG8_STAGE(PG8_SA(0, 1), cA + hstepA, voffA);
    if (wr == 1) PG8_BAR;
    PG8_WAIT_V(2); PG8_BAR;
    PG8_STAGE(PG8_SB(1, 0), cB + kstep, voffB); PG8_STAGE(PG8_SA(1, 0), cA + kstep, voffA); PG8_STAGE(PG8_SB(1, 1), cB + hstepB + kstep, voffB);
    PG8_WAIT_V(6); PG8_BAR;
    for (;;) {
        const bool has_next = S.next(ui + 1, nxt);
        const char* nA = has_next ? (const char*)g.A + (size_t)nxt.pm * g.sAm : cA; const char* nB = has_next ? (const char*)g.Bt + (size_t)nxt.pn * tstepB + (size_t)nxt.pm * g.sBm : cB;
        for (int t = 0; t < nt; t += 2) {
            const bool last = (t == nt - 2);
            const char* a1 = cA + (size_t)(t + 1) * kstep;
            const char* a2 = last ? nA : cA + (size_t)(t + 2) * kstep; const char* b2 = last ? nB : cB + (size_t)(t + 2) * kstep;
            const char* a3 = a2 + kstep; const char* b3 = b2 + kstep;
            PG8_LDB(B0, 0, 0); PG8_LDB(B1, 0, 1); PG8_SCHED; PG8_LDA(At, 0, 0); PG8_STAGE(PG8_SA(1, 1), a1 + hstepA, voffA);
            PG8_WAIT_V(8); PG8_WAIT_L(0); PG8_BAR; PG8_MMA(0, 0, At, B0); PG8_MMA(0, 1, At, B1); PG8_BAR; PG8_SCHED;
            PG8_LDA(At, 0, 1); PG8_STAGE(PG8_SB(0, 0), b2, voffB); PG8_STAGE(PG8_SB(0, 1), b2 + hstepB, voffB); PG8_STAGE(PG8_SA(0, 0), a2, voffA);
            PG8_WAIT_V(8); PG8_WAIT_L(0); PG8_BAR; PG8_MMA(1, 0, At, B0); PG8_MMA(1, 1, At, B1); PG8_BAR; PG8_SCHED;
            PG8_LDB(B0, 1, 0); PG8_LDB(B1, 1, 1); PG8_SCHED; PG8_LDA(At, 1, 0); PG8_STAGE(PG8_SA(0, 1), a2 + hstepA, voffA);
            PG8_WAIT_V(8); PG8_WAIT_L(0); PG8_BAR; PG8_MMA(0, 0, At, B0); PG8_MMA(0, 1, At, B1); PG8_BAR; PG8_SCHED;
            PG8_LDA(At, 1, 1); PG8_STAGE(PG8_SB(1, 0), b3, voffB); PG8_STAGE(PG8_SB(1, 1), b3 + hstepB, voffB); PG8_STAGE(PG8_SA(1, 0), a3, voffA);
            PG8_WAIT_V(8); PG8_WAIT_L(0); PG8_BAR; PG8_MMA(1, 0, At, B0); PG8_MMA(1, 1, At, B1); PG8_BAR; PG8_SCHED;
        }
        if (wr == 0) PG8_BAR;
        epilogue(acc, g, cur, wr, wc, fr, fq);
        if (!has_next) break;
#pragma unroll
        for (int a = 0; a < 2; ++a)
#pragma unroll
            for (int b = 0; b < 2; ++b)
#pragma unroll
                for (int m = 0; m < 4; ++m)
#pragma unroll
                    for (int n = 0; n < 2; ++n) acc[a][b][m][n] = (f32x4){0.f, 0.f, 0.f, 0.f};
        cur = nxt; cA = nA; cB = nB; ++ui;
        if (wr == 1) PG8_BAR;
    }
    PG8_WAIT_V(0);
    PG8_BAR;
#undef PG8_SA
#undef PG8_SB
#undef PG8_STAGE
#undef PG8_LDA
#undef PG8_LDB
#undef PG8_MMA
#undef PG8_WAIT_V
#undef PG8_WAIT_L
#undef PG8_BAR
#undef PG8_SCHED
}
}
using pg8::GemmDesc;

__device__ __forceinline__ void wtrans_tile(const float* src, int ldsrc, int k0, int n0, const float* gain, bf16_t* dst, int ldd, LAS bf16_t* T, int lane) {
#pragma unroll 16
    for (int i = 0; i < 64; ++i) {
        float v = src[(size_t)(k0 + i) * ldsrc + n0 + lane];
        if (gain) v *= gain[k0 + i];
        T[lane * 72 + i] = (bf16_t)f2bf(v);
    }
    wave_lds_fence();
#pragma unroll
    for (int it = 0; it < 8; ++it) { const int n = it * 8 + (lane >> 3), kc = (lane & 7) * 8; const u32x4 v = *(const LAS u32x4*)(T + n * 72 + kc); *(u32x4*)(dst + (size_t)n * ldd + kc) = v; }
    wave_lds_fence();
}
template <class T> __device__ __forceinline__ void vrelayout(const T* src, int ld, int nkeys, bf16_t* dstblk, float* fout, int fld, LAS bf16_t* Sx, int lane) {
    const int r = lane & 15, g = lane >> 4;
    for (int i = 0; i < nkeys / 4; ++i) { const int key = i * 4 + g; float f[8]; load8(src + (size_t)key * ld + r * 8, f);
        if (fout) store8f(fout + (size_t)key * fld + r * 8, f);
        *(LAS u32x4*)(Sx + key * 136 + r * 8) = pack8(f); }
    wave_lds_fence();
#pragma unroll
    for (int dt = 0; dt < 8; ++dt) {
        unsigned w[4];
#pragma unroll
        for (int p = 0; p < 4; ++p) { const int key = 8 * g + 2 * p;
            const unsigned lo = Sx[key * 136 + dt * 16 + r], hi = Sx[(key + 1) * 136 + dt * 16 + r]; w[p] = lo | (hi << 16); }
        bf16_t* d = dstblk + (dt * 64 + lane) * 8;
        if (nkeys == 32 || g < 2) *(u32x4*)d = (u32x4){w[0], w[1], w[2], w[3]}; else *(u32x4*)d = (u32x4){0u, 0u, 0u, 0u};
    }
    wave_lds_fence();
}

__device__ __forceinline__ float gmax4(float v) {
    unsigned u = __builtin_bit_cast(unsigned, v);
    auto a = __builtin_amdgcn_permlane16_swap(u, u, false, false);
    float m = fmaxf(__builtin_bit_cast(float, (unsigned)a[0]), __builtin_bit_cast(float, (unsigned)a[1]));
    u = __builtin_bit_cast(unsigned, m);
    auto b = __builtin_amdgcn_permlane32_swap(u, u, false, false);
    return fmaxf(__builtin_bit_cast(float, (unsigned)b[0]), __builtin_bit_cast(float, (unsigned)b[1]));
}
__device__ __forceinline__ float gsum4(float v) {
    unsigned u = __builtin_bit_cast(unsigned, v);
    auto a = __builtin_amdgcn_permlane16_swap(u, u, false, false);
    float m = __builtin_bit_cast(float, (unsigned)a[0]) + __builtin_bit_cast(float, (unsigned)a[1]);
    u = __builtin_bit_cast(unsigned, m);
    auto b = __builtin_amdgcn_permlane32_swap(u, u, false, false);
    return __builtin_bit_cast(float, (unsigned)b[0]) + __builtin_bit_cast(float, (unsigned)b[1]);
}
struct AttnJob {
    const bf16_t* Q; const bf16_t* K; const bf16_t* K2; const bf16_t* Vf; const float* krstd; const float* bias; const bf16_t* gate; bf16_t* O;
    int ldq, ldk, ldk2, ldg, ldo, k0, k1, qpos0, nq, tbw, ldv; float m0, l0;
    const float* qgain2; int qpos;
    const float* qgain;
};
template <int DK, bool LDSRC>
__device__ __forceinline__ void attn_tile(const bf16x8 (&qf)[2][DK / 32], f32x4 (&o)[8][2], float (&mrun)[2], float (&lrun)[2],
                                          const bf16_t* Kg, int ldk, const bf16_t* K2g, int ldk2, const bf16_t* Vblk, int vdt, int vlane, const float* rsg, const float* biasg,
                                          LAS const unsigned char* slot, LAS const float* tbl, int brel, bool half, bool has_rs, bool has_bias, int lane) {
    constexpr int NDS = DK / 32;
    const int r = lane & 15, g = lane >> 4;
    f32x4 s[2][2];
#pragma unroll
    for (int kt = 0; kt < 2; ++kt) {
        bf16x8 kf[NDS];
        if constexpr (LDSRC) {
#pragma unroll
            for (int ds = 0; ds < 4; ++ds) kf[ds] = *(LAS const bf16x8*)(slot + (((kt * 16 + ds * 4 + g) * 16 + r) << 4));
            if constexpr (DK == 192) {
#pragma unroll
                for (int d2 = 0; d2 < 2; ++d2) kf[4 + d2] = *(LAS const bf16x8*)(slot + 16384 + ((kt * 128 + (d2 * 4 + g) * 16 + r) << 4));
            }
        } else {
            const int krow = 8 * (r >> 2) + 4 * kt + (r & 3);
            const bf16_t* kp = Kg + (size_t)krow * ldk + g * 8;
#pragma unroll
            for (int ds = 0; ds < 4; ++ds) kf[ds] = *(const bf16x8*)(kp + ds * 32);
            if constexpr (DK == 192) { const bf16_t* kp2 = K2g + (size_t)krow * ldk2 + g * 8; kf[4] = *(const bf16x8*)kp2; kf[5] = *(const bf16x8*)(kp2 + 32); }
        }
#pragma unroll
        for (int qg = 0; qg < 2; ++qg) { f32x4 a = (f32x4){0.f, 0.f, 0.f, 0.f};
#pragma unroll
            for (int ds = 0; ds < NDS; ++ds) a = __builtin_amdgcn_mfma_f32_16x16x32_bf16(kf[ds], qf[qg][ds], a, 0, 0, 0);
            s[kt][qg] = a; }
        if constexpr (DK == 192 && !LDSRC) {
            float ssq = 0.f;
#pragma unroll
            for (int ds = 0; ds < NDS; ++ds) { float f[8]; unpack8(__builtin_bit_cast(u32x4, kf[ds]), f); ssq += sumsq8(f); }
            ssq = gsum4(ssq);
            const float rk = rsqrtf(ssq * (1.0f / 192.0f) + EPS);
            f32x4 rs; rs[0] = __shfl(rk, 4 * g); rs[1] = __shfl(rk, 4 * g + 1); rs[2] = __shfl(rk, 4 * g + 2); rs[3] = __shfl(rk, 4 * g + 3);
            s[kt][0] *= rs; s[kt][1] *= rs;
        }
    }
    if (has_rs && !(DK == 192 && !LDSRC)) {
#pragma unroll
        for (int kt = 0; kt < 2; ++kt) {
            f32x4 rs;
            if constexpr (LDSRC) rs = *(LAS const f32x4*)(slot + 20480 + ((8 * g + 4 * kt) << 2));
            else rs = (f32x4){rsg[8 * g + 4 * kt], rsg[8 * g + 4 * kt + 1], rsg[8 * g + 4 * kt + 2], rsg[8 * g + 4 * kt + 3]};
            s[kt][0] *= rs; s[kt][1] *= rs;
        }
    }
    if (has_bias) {
#pragma unroll
        for (int kt = 0; kt < 2; ++kt)
#pragma unroll
            for (int qg = 0; qg < 2; ++qg)
#pragma unroll
                for (int j = 0; j < 4; ++j) { const int idx = brel + qg * 16 + r - (8 * g + 4 * kt + j);
                    if constexpr (LDSRC) s[kt][qg][j] += tbl[idx]; else s[kt][qg][j] += biasg[idx]; }
    }
    if (half && g >= 2) { s[0][0] = (f32x4){-1e30f, -1e30f, -1e30f, -1e30f}; s[0][1] = s[0][0]; s[1][0] = s[0][0]; s[1][1] = s[0][0]; }
    bf16x8 pf[2]; float alpha[2];
#pragma unroll
    for (int qg = 0; qg < 2; ++qg) {
        float mx = fmaxf(fmaxf(fmaxf(s[0][qg][0], s[0][qg][1]), fmaxf(s[0][qg][2], s[0][qg][3])), fmaxf(fmaxf(s[1][qg][0], s[1][qg][1]), fmaxf(s[1][qg][2], s[1][qg][3])));
        mx = gmax4(mx);
        const float mn = fmaxf(mrun[qg], mx);
        alpha[qg] = fexp2(mrun[qg] - mn); mrun[qg] = mn;
        float p[8];
#pragma unroll
        for (int j = 0; j < 4; ++j) { p[j] = fexp2(s[0][qg][j] - mn); p[4 + j] = fexp2(s[1][qg][j] - mn); }
        lrun[qg] = lrun[qg] * alpha[qg] + ((p[0] + p[1]) + (p[2] + p[3])) + ((p[4] + p[5]) + (p[6] + p[7]));
        const u32x4 pk = pack8(p); pf[qg] = __builtin_bit_cast(bf16x8, pk);
    }
#pragma unroll
    for (int dt = 0; dt < 8; ++dt) {
        bf16x8 vf;
        if constexpr (LDSRC) vf = *(LAS const bf16x8*)(slot + 8192 + ((dt * 64 + lane) << 4)); else vf = *(const bf16x8*)(Vblk + (size_t)dt * vdt + vlane);
#pragma unroll
        for (int qg = 0; qg < 2; ++qg) { f32x4 a = o[dt][qg] * alpha[qg]; o[dt][qg] = __builtin_amdgcn_mfma_f32_16x16x32_bf16(vf, pf[qg], a, 0, 0, 0); }
    }
}
__device__ __forceinline__ void qnorm_frags(bf16x8 (&qf)[2][4], const float* gain, int lane) {
    const int g = lane >> 4;
#pragma unroll
    for (int qg = 0; qg < 2; ++qg) {
        float f[4][8]; float ss = 0.f;
#pragma unroll
        for (int ds = 0; ds < 4; ++ds) { unpack8(__builtin_bit_cast(u32x4, qf[qg][ds]), f[ds]); ss += sumsq8(f[ds]); }
        ss = gsum4(ss);
        const float rstd = rsqrtf(ss * (1.0f / 128.0f) + EPS) * (0.08838834764831845f * LOG2E);
#pragma unroll
        for (int ds = 0; ds < 4; ++ds) { const float* gp = gain + ds * 32 + g * 8;
#pragma unroll
            for (int e = 0; e < 8; ++e) f[ds][e] = f[ds][e] * rstd * gp[e];
            qf[qg][ds] = __builtin_bit_cast(bf16x8, pack8(f[ds])); }
    }
}
__device__ __forceinline__ void rope_cs(int pos, int i, float& cs, float& sn) {
    const float inv = fexp2(-(float)i * (13.287712379549449f / 32.0f));
    const float rev = (float)pos * inv * 0.15915494309189535f; const float fr = rev - rintf(rev);
    cs = __builtin_amdgcn_cosf(fr); sn = __builtin_amdgcn_sinf(fr);
}
__device__ __forceinline__ void qnorm_frags192(bf16x8 (&qf)[2][6], const float* gq, const float* gk, int pos0, int lane) {
    const int r = lane & 15, g = lane >> 4;
#pragma unroll
    for (int qg = 0; qg < 2; ++qg) {
        float f[6][8]; float ss = 0.f;
#pragma unroll
        for (int ds = 0; ds < 6; ++ds) unpack8(__builtin_bit_cast(u32x4, qf[qg][ds]), f[ds]);
        const int pos = pos0 + qg * 16 + r;
#pragma unroll
        for (int e = 0; e < 8; ++e) { float cs, sn; rope_cs(pos, g * 8 + e, cs, sn); const float x1 = f[4][e], x2 = f[5][e]; f[4][e] = x1 * cs - x2 * sn; f[5][e] = x1 * sn + x2 * cs; }
#pragma unroll
        for (int ds = 0; ds < 6; ++ds) ss += sumsq8(f[ds]);
        ss = gsum4(ss);
        const float rstd = rsqrtf(ss * (1.0f / 192.0f) + EPS) * (0.07216878364870322f * LOG2E);
#pragma unroll
        for (int ds = 0; ds < 6; ++ds) { const int d0 = ds * 32 + g * 8;
#pragma unroll
            for (int e = 0; e < 8; ++e) f[ds][e] = f[ds][e] * rstd * gq[d0 + e] * gk[d0 + e];
            qf[qg][ds] = __builtin_bit_cast(bf16x8, pack8(f[ds])); }
    }
}
template <int DK> __device__ __forceinline__ void attn_tile64(const bf16x8 (&qf)[2][DK / 32], f32x4 (&o)[8][2], float (&mrun)[2], float (&lrun)[2],
                                            LAS const unsigned char* slotA, LAS const unsigned char* slotB, LAS const float* tbl, int brel, bool has_bias, int lane) {
    const int r = lane & 15, g = lane >> 4;
    f32x4 s[4][2];
#pragma unroll
    for (int k4 = 0; k4 < 4; ++k4) {
        LAS const unsigned char* slot = (k4 < 2) ? slotA : slotB; const int kt = k4 & 1;
        bf16x8 kf[DK / 32];
#pragma unroll
        for (int ds = 0; ds < 4; ++ds) kf[ds] = *(LAS const bf16x8*)(slot + (((kt * 16 + ds * 4 + g) * 16 + r) << 4));
        if constexpr (DK == 192) {
#pragma unroll
            for (int d2 = 0; d2 < 2; ++d2) kf[4 + d2] = *(LAS const bf16x8*)(slot + 16384 + ((kt * 128 + (d2 * 4 + g) * 16 + r) << 4));
        }
#pragma unroll
        for (int qg = 0; qg < 2; ++qg) { f32x4 a = (f32x4){0.f, 0.f, 0.f, 0.f};
#pragma unroll
            for (int ds = 0; ds < DK / 32; ++ds) a = __builtin_amdgcn_mfma_f32_16x16x32_bf16(kf[ds], qf[qg][ds], a, 0, 0, 0);
            s[k4][qg] = a; }
        if constexpr (DK == 192) { const f32x4 rs = *(LAS const f32x4*)(slot + 20480 + ((8 * g + 4 * kt) << 2)); s[k4][0] *= rs; s[k4][1] *= rs; }
    }
    if (has_bias) {
#pragma unroll
        for (int k4 = 0; k4 < 4; ++k4)
#pragma unroll
            for (int qg = 0; qg < 2; ++qg)
#pragma unroll
                for (int j = 0; j < 4; ++j) s[k4][qg][j] += tbl[brel + qg * 16 + r - (32 * (k4 >> 1) + 8 * g + 4 * (k4 & 1) + j)];
    }
    bf16x8 pf[2][2]; float alpha[2];
#pragma unroll
    for (int qg = 0; qg < 2; ++qg) {
        float mx = -1e30f;
#pragma unroll
        for (int k4 = 0; k4 < 4; ++k4) mx = fmaxf(mx, fmaxf(fmaxf(s[k4][qg][0], s[k4][qg][1]), fmaxf(s[k4][qg][2], s[k4][qg][3])));
        mx = gmax4(mx);
        const float mn = fmaxf(mrun[qg], mx);
        alpha[qg] = fexp2(mrun[qg] - mn); mrun[qg] = mn;
        float sum = 0.f;
#pragma unroll
        for (int t = 0; t < 2; ++t) { float p[8];
#pragma unroll
            for (int j = 0; j < 4; ++j) { p[j] = fexp2(s[2 * t][qg][j] - mn); p[4 + j] = fexp2(s[2 * t + 1][qg][j] - mn); }
            sum += ((p[0] + p[1]) + (p[2] + p[3])) + ((p[4] + p[5]) + (p[6] + p[7]));
            const u32x4 pk = pack8(p); pf[t][qg] = __builtin_bit_cast(bf16x8, pk); }
        lrun[qg] = lrun[qg] * alpha[qg] + sum;
    }
#pragma unroll
    for (int dt = 0; dt < 8; ++dt) {
        const bf16x8 v0 = *(LAS const bf16x8*)(slotA + 8192 + ((dt * 64 + lane) << 4)), v1 = *(LAS const bf16x8*)(slotB + 8192 + ((dt * 64 + lane) << 4));
#pragma unroll
        for (int qg = 0; qg < 2; ++qg) { f32x4 a = o[dt][qg] * alpha[qg]; a = __builtin_amdgcn_mfma_f32_16x16x32_bf16(v0, pf[0][qg], a, 0, 0, 0); o[dt][qg] = __builtin_amdgcn_mfma_f32_16x16x32_bf16(v1, pf[1][qg], a, 0, 0, 0); }
    }
}
__device__ __forceinline__ void attn_store(const f32x4 (&o)[8][2], const float (&inv)[2], const bf16_t* gate, int ldg, bf16_t* O, int ldo, int nq, int lane) {
    const int r = lane & 15, g = lane >> 4;
#pragma unroll
    for (int qg = 0; qg < 2; ++qg) {
        const int row = qg * 16 + r;
        if (row < nq) {
            const bf16_t* gp = gate + (size_t)row * ldg + 4 * g; bf16_t* op = O + (size_t)row * ldo + 4 * g;
#pragma unroll
            for (int dt = 0; dt < 8; ++dt) {
                const u32x2 gv = *(const u32x2*)(gp + dt * 16);
                float gt[4] = {bflo(gv.x), bfhi(gv.x), bflo(gv.y), bfhi(gv.y)}, ov[4];
#pragma unroll
                for (int j = 0; j < 4; ++j) { const float sg = gt[j] / (1.0f + __expf(-gt[j])); ov[j] = o[dt][qg][j] * inv[qg] * sg; }
                *(u32x2*)(op + dt * 16) = (u32x2){cvt_pk_bf16(ov[0], ov[1]), cvt_pk_bf16(ov[2], ov[3])};
            }
        }
    }
}

typedef const __attribute__((address_space(4))) KP* KPP;
typedef const float* cfp_t; typedef const __attribute__((address_space(4))) cfp_t* cfp_as4p;
struct PView { cfp_as4p in; float* out; unsigned char* ws; };
struct Ctx {
    PView p; LAS unsigned char* lds; int tid, lane, wid, G, bx, gw, NW;
    __device__ __forceinline__ bf16_t* wsb(size_t off) const { return (bf16_t*)(p.ws + off); }
    __device__ __forceinline__ float* wsf(size_t off) const { return (float*)(p.ws + off); }
    __device__ __forceinline__ LAS bf16_t* wlds() const { return (LAS bf16_t*)(lds + wid * 16384); }
};

__device__ __forceinline__ void norm_row_2048(const float* x, bf16_t* xn, float* ycopy, int lane, const float* part = nullptr) {
    f32x4 v[8]; float ss = 0.f;
#pragma unroll
    for (int i = 0; i < 8; ++i) v[i] = *(const f32x4*)(x + i * 256 + lane * 4);
    if (part) {
        for (int ks = 0; ks < 8; ++ks)
#pragma unroll
            for (int i = 0; i < 8; ++i) v[i] += *(const f32x4*)(part + (size_t)ks * 128 * 2048 + i * 256 + lane * 4);
    }
#pragma unroll
    for (int i = 0; i < 8; ++i) ss += v[i][0] * v[i][0] + v[i][1] * v[i][1] + v[i][2] * v[i][2] + v[i][3] * v[i][3];
    ss = gsum<64>(ss);
    const float rstd = rsqrtf(ss * (1.0f / 2048.0f) + EPS);
#pragma unroll
    for (int i = 0; i < 8; ++i) {
        if (ycopy) *(f32x4*)(ycopy + i * 256 + lane * 4) = v[i];
        *(u32x2*)(xn + i * 256 + lane * 4) = (u32x2){cvt_pk_bf16(v[i][0] * rstd, v[i][1] * rstd), cvt_pk_bf16(v[i][2] * rstd, v[i][3] * rstd)};
    }
}

__device__ __forceinline__ void norm_row_2048_bf16(const bf16_t* x, bf16_t* xn, int lane) {
    u32x4 u[4]; float f[4][8]; float ss = 0.f;
#pragma unroll
    for (int i = 0; i < 4; ++i) u[i] = *(const u32x4*)(x + i * 512 + lane * 8);
#pragma unroll
    for (int i = 0; i < 4; ++i) { unpack8(u[i], f[i]); ss += sumsq8(f[i]); }
    ss = gsum<64>(ss);
    const float rstd = rsqrtf(ss * (1.0f / 2048.0f) + EPS);
#pragma unroll
    for (int i = 0; i < 4; ++i) {
#pragma unroll
        for (int e = 0; e < 8; ++e) f[i][e] *= rstd;
        *(u32x4*)(xn + i * 512 + lane * 8) = pack8(f[i]); }
}

__device__ __forceinline__ void nphase(const Ctx& c, int l) {
    const int kind = l % 3, j = l / 3;
    bf16_t* XN = c.wsb(WS_XN);
    for (int row = c.gw; row < MT; row += c.NW) {
        if (row < NR) {
            if (row < NP) { if (l == 0) norm_row_2048(c.p.in[0] + (size_t)row * DM, XN + (size_t)row * DM, nullptr, c.lane);
                else norm_row_2048_bf16((l == 3 ? c.wsb(WS_DYN + 200 * MiB) : (const bf16_t*)c.p.out) + (size_t)row * DM, XN + (size_t)row * DM, c.lane); }
            else norm_row_2048((l <= 1) ? c.p.in[1] + (size_t)(row - NP) * DM : c.p.out + (size_t)row * DM, XN + (size_t)row * DM, (l == 0) ? nullptr : c.p.out + (size_t)row * DM, c.lane,
                               (l == 0) ? nullptr : c.wsf(WS_PART) + (size_t)(row - NP) * DM);
        } else {
#pragma unroll
            for (int i = 0; i < 4; ++i) *(u32x4*)(XN + (size_t)row * DM + i * 512 + c.lane * 8) = (u32x4){0u, 0u, 0u, 0u};
        }
    }
    const int nin = (kind == 0) ? 5120 : (kind == 1 ? 3392 : 7168);
    const float* win = (kind == 0) ? c.p.in[18] + (size_t)j * 2048 * 5120 : (kind == 1 ? c.p.in[22] : c.p.in[29]);
    const float* gn = c.p.in[12] + l * 2048;
    const int t_in = 32 * (nin / 64), t_out = 32 * 32, t_qb = (kind == 1) ? 8 * 36 : 0, t_kvb = (kind == 1) ? 4 * 48 : 0;
    const int ttot = t_in + t_out + t_qb + t_kvb;
    LAS bf16_t* T = c.wlds();
    for (int t = c.gw; t < ttot; t += c.NW) {
        if (t < t_in) {
            const int kt = t % 32, ntile = t / 32; int n0 = ntile * 64, nd = n0;
            if (kind == 1) { if (n0 >= 1344) nd = n0 - 1344 + 1280; else if (n0 >= 832) nd = n0 - 832 + 768; else if (n0 >= 768) nd = n0 - 768 + 3328; }
            wtrans_tile(win, nin, kt * 64, n0, gn, c.wsb(WS_WIN) + (size_t)nd * 2048 + kt * 64, 2048, T, c.lane);
        } else if (t < t_in + t_out) {
            const int u = t - t_in, kt = u % 32, n0 = (u / 32) * 64;
            wtrans_tile(c.p.in[13] + (size_t)l * 2048 * 2048, 2048, kt * 64, n0, nullptr, c.wsb(WS_WOUT) + (size_t)n0 * 2048 + kt * 64, 2048, T, c.lane);
        } else if (t < t_in + t_out + t_qb) {
            const int u = t - t_in - t_out, kt = u % 8, n0 = (u / 8) * 64;
            wtrans_tile(c.p.in[24], 2304, kt * 64, n0, c.p.in[23], c.wsb(WS_WQB) + (size_t)n0 * 512 + kt * 64, 512, T, c.lane);
        } else {
            const int u = t - t_in - t_out - t_qb, kt = u % 4, n0 = (u / 4) * 64;
            const int h = n0 / 256, tt = (n0 % 256) / 128, d0 = n0 % 128;
            wtrans_tile(c.p.in[26], 3072, kt * 64, n0, nullptr, c.wsb(tt ? WS_WV : WS_WK) + (size_t)(h * 128 + d0) * 256 + kt * 64, 256, T, c.lane);
        }
    }
}

__device__ __forceinline__ void conv_rows(const Ctx& c, const float* src, size_t nelem, int W, int R, int R2, bf16_t* dst) {
    for (size_t e0 = (size_t)c.gw * 2048 + c.lane * 8; e0 < nelem; e0 += (size_t)c.NW * 2048) {
        float f[4][8];
#pragma unroll
        for (int q = 0; q < 4; ++q) load8(src + e0 + q * 512, f[q]);
#pragma unroll
        for (int q = 0; q < 4; ++q) { const size_t e = e0 + q * 512; const size_t row = e / W; const int col = (int)(e % W); const size_t bb = row / R; const int r = (int)(row % R);
            *(u32x4*)(dst + ((size_t)bb * R2 + r) * W + col) = pack8(f[q]); }
    }
}

__device__ __forceinline__ void prologue(const Ctx& c) {
    const PView& p = c.p;
    conv_rows(c, p.in[3], (size_t)2 * 8 * 128 * 512, 512, 128, 160, c.wsb(WS_KDA));
    conv_rows(c, p.in[7], (size_t)8 * 512 * 1536, 1536, 512, 544, c.wsb(WS_KDC));
    conv_rows(c, p.in[9], (size_t)4 * 8 * 256 * 512, 512, 256, 256, c.wsb(WS_KCMEM));
    conv_rows(c, p.in[5], (size_t)8 * 4096 * 256, 256, 4096, KVB, c.wsb(WS_CKVD));
    conv_rows(c, p.in[6], (size_t)8 * 4096 * 64, 64, 4096, KVB, c.wsb(WS_KRD));
    LAS bf16_t* Sx = c.wlds();
    for (int t = c.gw; t < 2 * 8 * 4 * 4; t += c.NW) { const int kb = t % 4, h = (t / 4) % 4, b = (t / 16) % 8, j = t / 128;
        vrelayout(p.in[4] + ((size_t)((j * 8 + b) * 128 + kb * 32) * 4 + h) * 128, 512, 32, c.wsb(WS_VFDA) + j * VFDA_L + (size_t)((b * 4 + h) * 5 + kb) * 4096, nullptr, 0, Sx, c.lane); }
    for (int t = c.gw; t < 8 * 12 * 16; t += c.NW) { const int kb = t % 16, h = (t / 16) % 12, b = t / 192;
        vrelayout(p.in[8] + ((size_t)(b * 512 + kb * 32) * 12 + h) * 128, 1536, 32, c.wsb(WS_VFDC) + (size_t)((b * 12 + h) * 17 + kb) * 4096, nullptr, 0, Sx, c.lane); }
    for (int t = c.gw; t < 4 * 8 * 4 * 8; t += c.NW) { const int kb = t % 8, h = (t / 8) % 4, lb = t / 32;
        vrelayout(p.in[10] + ((size_t)(lb * 256 + kb * 32) * 4 + h) * 128, 512, 32, c.wsb(WS_VFCMEM) + (size_t)((lb * 4 + h) * 8 + kb) * 4096, nullptr, 0, Sx, c.lane); }
    float* TBA = c.wsf(WS_TB); float* TBC = TBA + 12 * 256;
    for (int e = c.bx * 512 + c.tid; e < 12 * 256 + 12 * 640; e += c.G * 512) {
        if (e < 12 * 256) { const int h = e / 256, rel = (e % 256) - 64; const int n = rel < 0 ? -rel : rel;
            const int large = 8 + (n >= 12) + (n >= 16) + (n >= 23) + (n >= 32) + (n >= 46) + (n >= 64) + (n >= 91);
            const int bucket = (rel < 0 ? 16 : 0) + (n < 8 ? n : large);
            TBA[e] = p.in[11][bucket * 12 + h] * LOG2E;
        } else { const int u = e - 12 * 256, h = u / 640, rel = (u % 640) - 64; const int cl = (rel < -128 ? -128 : (rel > 128 ? 128 : rel)) + 128;
            TBC[u] = p.in[32][h * 257 + cl] * LOG2E; }
    }
    for (int row = c.gw; row < 2048; row += c.NW) norm_row_2048(p.in[2] + (size_t)row * DM, c.wsb(WS_DYN + DY_MEMN) + (size_t)row * DM, nullptr, c.lane);
    for (int t = c.gw; t < 4 * 32 * 16; t += c.NW) { const int kt = t % 32, nt = (t / 32) % 16, l = t / 512;
        wtrans_tile(p.in[15] + (size_t)l * 2048 * 1024, 1024, kt * 64, nt * 64, p.in[14] + l * 2048, c.wsb(WS_DYN + DY_WMEM) + (size_t)(l * 1024 + nt * 64) * 2048 + kt * 64, 2048, Sx, c.lane); }
    nphase(c, 0);
}

__device__ __forceinline__ void head_norm(float (&f)[8], const float* g, float scale, int lane) {
    const float ss = gsum<16>(sumsq8(f));
    const float rstd = rsqrtf(ss * (1.0f / 128.0f) + EPS) * scale;
    const float* gp = g + (lane & 15) * 8;
#pragma unroll
    for (int e = 0; e < 8; ++e) f[e] = f[e] * rstd * gp[e];
}

__device__ __forceinline__ void memp(const Ctx& c) {
    const bf16_t* ZM = c.wsb(WS_DYN + DY_ZM);
    for (int t = c.gw; t < 4 * 2048; t += c.NW) { const int l = t / 2048, row = t % 2048;
        float f[8]; load8(ZM + (size_t)row * 4096 + l * 1024 + c.lane * 8, f);
        head_norm(f, c.p.in[17] + l * 128, 1.0f, c.lane);
        store8f(c.p.out + O_MK + ((size_t)l * 2048 + row) * 512 + c.lane * 8, f);
        *(u32x4*)(c.wsb(WS_KMEM) + ((size_t)l * 2048 + row) * 512 + c.lane * 8) = pack8(f);
    }
    LAS bf16_t* Sx = c.wlds();
    for (int t = c.gw; t < 4 * 8 * 4 * 8; t += c.NW) { const int kb = t % 8, h = (t / 8) % 4, b = (t / 32) % 8, l = t / 256;
        vrelayout(ZM + (size_t)(b * 256 + kb * 32) * 4096 + l * 1024 + 512 + h * 128, 4096, 32, c.wsb(WS_VFMEM) + (size_t)(((l * 8 + b) * 4 + h) * 8 + kb) * 4096,
                  c.p.out + O_MV + ((size_t)(l * 8 + b) * 256 + kb * 32) * 512 + h * 128, 512, Sx, c.lane); }
}

struct LayerAC { int ldz, ko, vo, xo, go, nkh, keep, past, kdrows, nblk; size_t okp, ovp, oks, ovs; bf16_t* Z; bf16_t* Kdec; bf16_t* Vfdec; bf16_t* Vf; const float* gq; const float* gk; const float* gxq; const float* tb; int tbw; const float* sink; };
__device__ __forceinline__ LayerAC layer_ac(const Ctx& c, int l) {
    LayerAC L; const int kind = l % 3, j = l / 3;
    L.Z = c.wsb(WS_DYN); L.gxq = c.p.in[16] + l * 128;
    if (kind == 0) { L.ldz = 5120; L.ko = 1536; L.vo = 2048; L.xo = 2560; L.go = 3072; L.nkh = 4; L.keep = 128; L.past = 128; L.kdrows = 160; L.nblk = 5;
        L.okp = O_AKP; L.ovp = O_AVP; L.oks = O_AKS; L.ovs = O_AVS;
        L.Kdec = c.wsb(WS_KDA) + j * KDA_L; L.Vfdec = c.wsb(WS_VFDA) + j * VFDA_L; L.Vf = c.wsb(WS_DYN + DY_VFA); L.gq = c.p.in[19] + j * 128; L.gk = c.p.in[20] + j * 128;
        L.tb = c.wsf(WS_TB); L.tbw = 256; L.sink = c.p.in[21] + j * 12;
    } else { L.ldz = 7168; L.ko = 1536; L.vo = 3072; L.xo = 4608; L.go = 5120; L.nkh = 12; L.keep = 512; L.past = 512; L.kdrows = 544; L.nblk = 17;
        L.okp = O_CKP; L.ovp = O_CVP; L.oks = O_CKS; L.ovs = O_CVS;
        L.Kdec = c.wsb(WS_KDC); L.Vfdec = c.wsb(WS_VFDC); L.Vf = c.wsb(WS_DYN + DY_VFC); L.gq = c.p.in[30]; L.gk = c.p.in[31];
        L.tb = c.wsf(WS_TB) + 12 * 256; L.tbw = 640; L.sink = nullptr; }
    return L;
}
constexpr float QS128 = 0.08838834764831845f * LOG2E;
constexpr float QS192 = 0.07216878364870322f * LOG2E;

__device__ __forceinline__ void post_ac(const Ctx& c, int l) {
    const LayerAC L = layer_ac(c, l); const int j = l / 3, nk = L.nkh * 128;
    const int nkc = L.nkh / 4;
    for (int row = c.gw; row < NR; row += c.NW) {
        bf16_t* zr = L.Z + (size_t)row * L.ldz;
        const bool samp = row >= NP; const int b = samp ? (row - NP) / DEC : row / SEQ, s = samp ? (row - NP) % DEC : row % SEQ;
        u32x4 vk[3];
#pragma unroll
        for (int ch = 0; ch < 3; ++ch) vk[ch] = (ch < nkc) ? *(const u32x4*)(zr + L.ko + ch * 512 + c.lane * 8) : (u32x4){0u, 0u, 0u, 0u};
#pragma unroll
        for (int ch = 0; ch < 3; ++ch) if (ch < nkc) { const int col = ch * 512 + c.lane * 8; float f[8]; unpack8(vk[ch], f); head_norm(f, L.gk, 1.0f, c.lane);
            const u32x4 pk = pack8(f); *(u32x4*)(zr + L.ko + col) = pk;
            if (samp) { store8f(c.p.out + L.oks + ((size_t)(j * 8 + b) * DEC + s) * nk + col, f); *(u32x4*)(L.Kdec + ((size_t)b * L.kdrows + L.past + s) * nk + col) = pk; }
            else if (s >= SEQ - L.keep) store8f(c.p.out + L.okp + ((size_t)(j * 8 + b) * L.keep + (s - (SEQ - L.keep))) * nk + col, f); }
    }
    LAS bf16_t* Sx = c.wlds();
    const int nvp = 8 * L.nkh * 64;
    for (int t = c.gw; t < nvp + 8 * L.nkh; t += c.NW) {
        if (t < nvp) { const int kb = t % 64, bh = t / 64, b = bh / L.nkh, h = bh % L.nkh;
            float* fo = (kb * 32 >= SEQ - L.keep) ? c.p.out + L.ovp + ((size_t)(j * 8 + b) * L.keep + (kb * 32 - (SEQ - L.keep))) * nk + h * 128 : nullptr;
            vrelayout(L.Z + (size_t)(b * SEQ + kb * 32) * L.ldz + L.vo + h * 128, L.ldz, 32, L.Vf + (size_t)(bh * 64 + kb) * 4096, fo, nk, Sx, c.lane);
        } else { const int bh = t - nvp, b = bh / L.nkh, h = bh % L.nkh;
            vrelayout(L.Z + (size_t)(NP + b * DEC) * L.ldz + L.vo + h * 128, L.ldz, 16, L.Vfdec + (size_t)(bh * L.nblk + L.past / 32) * 4096,
                      c.p.out + L.ovs + ((size_t)(j * 8 + b) * DEC) * nk + h * 128, nk, Sx, c.lane); }
    }
}

constexpr int ZB_LD = 3584, ZB_CKV = 512, ZB_XQ = 768, ZB_G = 1280, ZB_KR = 3328;
__device__ __forceinline__ void post1_b(const Ctx& c, int l) {
    bf16_t* Z = c.wsb(WS_DYN + DY_ZB);
    for (int row = c.gw; row < NR; row += c.NW) {
        bf16_t* zr = Z + (size_t)row * ZB_LD;
        const bool samp = row >= NP; const int b = samp ? (row - NP) / DEC : row / SEQ, s = samp ? (row - NP) % DEC : row % SEQ;
        { float f[8]; bf16_t* pp = zr + c.lane * 8; load8(pp, f); const float rstd = rsqrtf(gsum<64>(sumsq8(f)) * (1.0f / 512.0f) + EPS);
#pragma unroll
            for (int e = 0; e < 8; ++e) f[e] *= rstd;
            *(u32x4*)pp = pack8(f); }
        {
            float f[8]; bf16_t* pp = zr + 512 + c.lane * 8; load8(pp, f); const float sq = sumsq8(f);
            const float s32 = gsum<32>(sq), s16 = gsum<16>(sq);
            if (c.lane < 32) { const float rstd = rsqrtf(s32 * (1.0f / 256.0f) + EPS); const float* gp = c.p.in[25] + c.lane * 8;
#pragma unroll
                for (int e = 0; e < 8; ++e) f[e] = f[e] * rstd * gp[e];
                const u32x4 pk = pack8(f); *(u32x4*)pp = pk;
                if (samp) { store8f(c.p.out + O_BCS + ((size_t)b * DEC + s) * 256 + c.lane * 8, f); *(u32x4*)(c.wsb(WS_CKVD) + ((size_t)b * KVB + PAST + s) * 256 + c.lane * 8) = pk; }
                else store8f(c.p.out + O_BCP + (size_t)row * 256 + c.lane * 8, f);
            }
            (void)s16;
        }
        if (c.lane >= 32) {
            const int i = c.lane - 32; const float x1 = bf1(zr[ZB_KR + i]), x2 = bf1(zr[ZB_KR + 32 + i]);
            float cs, sn; rope_cs(samp ? PAST + s : s, i, cs, sn);
            const float y1 = x1 * cs - x2 * sn, y2 = x1 * sn + x2 * cs;
            float* fo = samp ? c.p.out + O_BRS + ((size_t)b * DEC + s) * 64 : c.p.out + O_BRP + (size_t)row * 64;
            fo[i] = y1; fo[32 + i] = y2;
            bf16_t* kr = samp ? c.wsb(WS_KRD) + ((size_t)b * KVB + PAST + s) * 64 : c.wsb(WS_DYN + DY_KRP) + (size_t)row * 64;
            kr[i] = (bf16_t)f2bf(y1); kr[32 + i] = (bf16_t)f2bf(y2);
        }
    }
}
__device__ __forceinline__ bf16_t* vfdec_base(const Ctx& c, int b) { return b < 5 ? (bf16_t*)(c.p.ws + WS_DYN + (size_t)b * VFDEC_B) : (bf16_t*)((unsigned char*)(c.p.out + O_CKP) + (size_t)(b - 5) * VFDEC_B); }
__device__ __forceinline__ void post2_b(const Ctx& c, int round) {
    const bf16_t* Kb = c.wsb(WS_DYN + (round ? DY_KDEC : DY_KP));
    const bf16_t* KR = round ? c.wsb(WS_KRD) : c.wsb(WS_DYN + DY_KRP); float* RS = round ? c.wsf(WS_RSTDD) : c.wsf(WS_DYN + DY_RSTDP);
    const int nrows = round ? NB * KVB : NP, kpb = round ? KVB : SEQ, rld = round ? RSD_LD : SEQ;
    for (int row = c.gw; row < nrows; row += c.NW) {
        float kr = 0.f; if (c.lane < 8) { float f[8]; load8(KR + (size_t)row * 64 + c.lane * 8, f); kr = sumsq8(f); }
        kr = gsum<8>(kr); kr = __shfl(kr, 0);
        u32x4 vk[3];
#pragma unroll
        for (int ch = 0; ch < 3; ++ch) vk[ch] = *(const u32x4*)(Kb + (size_t)row * 1536 + ch * 512 + c.lane * 8);
#pragma unroll
        for (int ch = 0; ch < 3; ++ch) { float f[8]; unpack8(vk[ch], f); const float ss = gsum<16>(sumsq8(f)) + kr;
            if ((c.lane & 15) == 0) RS[((size_t)(row / kpb) * 12 + ch * 4 + (c.lane >> 4)) * rld + (row % kpb)] = rsqrtf(ss * (1.0f / 192.0f) + EPS); }
    }
}

#define MKCTXN(c) Ctx c; { int tid_ = threadIdx.x, bx_ = blockIdx.x, G_ = gridDim.x; KPP kp_ = (KPP)__builtin_amdgcn_kernarg_segment_ptr(); \
            asm volatile("" : "+s"(kp_), "+v"(tid_), "+s"(bx_), "+s"(G_)); \
            extern __shared__ __attribute__((aligned(16))) unsigned char smem[]; \
            c.lds = (LAS unsigned char*)smem; c.tid = tid_; c.lane = tid_ & 63; c.wid = __builtin_amdgcn_readfirstlane(tid_ >> 6); \
            c.G = G_; c.bx = bx_; c.gw = bx_ * 8 + c.wid; c.NW = G_ * 8; c.p.in = kp_->in; c.p.out = kp_->out; c.p.ws = kp_->ws; }
#define MKCTX MKCTXN(c)
struct SJob { const bf16_t* K; const bf16_t* K2; const bf16_t* Vf; const float* rs; int ldk, ldk2, K0, K1, ldv; };
constexpr int AT_NS = 5, AT_SLOT = 21504, AT_TBL = AT_NS * AT_SLOT;
template <int DK> __device__ __forceinline__ void attn_shared(const Ctx& c, const SJob& S, const AttnJob& J) {
    constexpr int NDS = DK / 32;
    LAS unsigned char* lds = c.lds; const int T = c.tid, lane = c.lane, w = c.wid, r = lane & 15, g = lane >> 4;
    LAS float* tbl = (LAS float*)(lds + AT_TBL + w * 2560);
    if (J.bias) { for (int i = lane; i < J.tbw; i += 64) tbl[i] = J.bias[i]; }
    bf16x8 qf[2][NDS];
#pragma unroll
    for (int qg = 0; qg < 2; ++qg)
#pragma unroll
        for (int ds = 0; ds < NDS; ++ds) qf[qg][ds] = *(const bf16x8*)(J.Q + (size_t)(qg * 16 + r) * J.ldq + ds * 32 + g * 8);
    if constexpr (DK == 128) { if (J.qgain) qnorm_frags(qf, J.qgain, lane); } else { qnorm_frags192(qf, J.qgain, J.qgain2, J.qpos, lane); }
    f32x4 o[8][2];
#pragma unroll
    for (int dt = 0; dt < 8; ++dt) { o[dt][0] = (f32x4){0.f, 0.f, 0.f, 0.f}; o[dt][1] = (f32x4){0.f, 0.f, 0.f, 0.f}; }
    float mrun[2] = {J.m0, J.m0}, lrun[2]; lrun[0] = lrun[1] = (g == 0) ? J.l0 : 0.f;
    asm volatile("s_waitcnt vmcnt(0)" ::: "memory"); wave_lds_fence();
    const int ntiles = (S.K1 - S.K0) >> 5;
    const bf16_t* ksrc = S.K + (size_t)(S.K0 + 8 * ((T & 15) >> 2) + 4 * (T >> 8) + (T & 3)) * S.ldk + ((T >> 4) & 15) * 8;
    const bf16_t* vsrc = S.ldv ? S.Vf + (size_t)(16 * (T >> 6) + (T & 15)) * S.ldv + S.K0 + 8 * ((T >> 4) & 3) : S.Vf + (size_t)(S.K0 >> 5) * 4096 + T * 8;
    const size_t vstep = S.ldv ? 32 : 4096;
    const bf16_t* xsrc = nullptr; size_t xstep = 0; unsigned xdst = 0;
    if constexpr (DK == 192) {
        if (w == 4) { xsrc = (const bf16_t*)(S.rs + S.K0) + lane * 8; xstep = 64; xdst = 20480; }
        else { const int p2 = T & 255; xsrc = S.K2 + (size_t)(S.K0 + 8 * ((p2 & 15) >> 2) + 4 * (p2 >> 7) + (p2 & 3)) * S.ldk2 + ((p2 >> 4) & 7) * 8; xstep = (size_t)32 * S.ldk2; xdst = 16384 + (w & 3) * 1024; }
    }
    const size_t kstep = (size_t)32 * S.ldk;
#define AT_ISSUE(tile, sl) do { const int _t = (tile) < ntiles ? (tile) : ntiles - 1; const unsigned _so = (unsigned)(sl) * AT_SLOT; \
        __builtin_amdgcn_global_load_lds((const unsigned*)(ksrc + _t * kstep), (LAS unsigned*)(lds + _so + w * 1024), 16, 0, 0); \
        __builtin_amdgcn_global_load_lds((const unsigned*)(vsrc + _t * vstep), (LAS unsigned*)(lds + _so + 8192 + w * 1024), 16, 0, 0); \
        if constexpr (DK == 192) __builtin_amdgcn_global_load_lds((const unsigned*)(xsrc + _t * xstep), (LAS unsigned*)(lds + _so + xdst), 16, 0, 0); } while (0)
    if constexpr (true) {
        const int npairs = ntiles >> 1;
        AT_ISSUE(0, 0); AT_ISSUE(1, 1);
        for (int jp = 0; jp < npairs; ++jp) {
            asm volatile("s_waitcnt vmcnt(0)" ::: "memory");
            __builtin_amdgcn_s_barrier(); asm volatile("" ::: "memory");
            const int ps = (jp & 1) * 2, pn = 2 - ps;
            if (jp + 1 < npairs) { AT_ISSUE(2 * jp + 2, pn); AT_ISSUE(2 * jp + 3, pn + 1); }
            const int kb = S.K0 + jp * 64;
            if (kb >= J.k0 && kb < J.k1)
                attn_tile64<DK>(qf, o, mrun, lrun, lds + ps * AT_SLOT, lds + (ps + 1) * AT_SLOT, tbl, J.qpos0 - kb + 64, J.bias != nullptr, lane);
        }
        asm volatile("s_waitcnt vmcnt(0)" ::: "memory");
        __builtin_amdgcn_s_barrier(); asm volatile("" ::: "memory");
    } else {
#pragma unroll
    for (int i = 0; i < AT_NS - 1; ++i) AT_ISSUE(i, i);
    int sl = 0;
    for (int i = 0; i < ntiles; ++i) {
        if constexpr (DK == 192) asm volatile("s_waitcnt vmcnt(9)" ::: "memory"); else asm volatile("s_waitcnt vmcnt(6)" ::: "memory");
        __builtin_amdgcn_s_barrier(); asm volatile("" ::: "memory");
        const int sn = (sl == 0) ? AT_NS - 1 : sl - 1;
        AT_ISSUE(i + AT_NS - 1, sn);
        const int kb = S.K0 + i * 32;
        if (kb >= J.k0 && kb < J.k1)
            attn_tile<DK, true>(qf, o, mrun, lrun, nullptr, 0, nullptr, 0, nullptr, 0, 0, nullptr, nullptr, lds + sl * AT_SLOT, tbl, J.qpos0 - kb + 64, false, DK == 192, J.bias != nullptr, lane);
        sl = (sl == AT_NS - 1) ? 0 : sl + 1;
    }
    asm volatile("s_waitcnt vmcnt(0)" ::: "memory");
    __builtin_amdgcn_s_barrier(); asm volatile("" ::: "memory");
    }
#undef AT_ISSUE
    float inv[2];
#pragma unroll
    for (int qg = 0; qg < 2; ++qg) { float l = lrun[qg]; l = gsum4(l); inv[qg] = 1.0f / l; }
    attn_store(o, inv, J.gate, J.ldg, J.O, J.ldo, 32, lane);
}
template <int DK> __device__ __forceinline__ void attn_split(const Ctx& c, const AttnJob& J) {
    constexpr int NDS = DK / 32;
    const int lane = c.lane, w = c.wid, r = lane & 15, g = lane >> 4;
    bf16x8 qf[2][NDS];
#pragma unroll
    for (int qg = 0; qg < 2; ++qg)
#pragma unroll
        for (int ds = 0; ds < NDS; ++ds) qf[qg][ds] = *(const bf16x8*)(J.Q + (size_t)(qg * 16 + r) * J.ldq + ds * 32 + g * 8);
    if constexpr (DK == 128) { if (J.qgain) qnorm_frags(qf, J.qgain, lane); } else { qnorm_frags192(qf, J.qgain, J.qgain2, J.qpos, lane); }
    f32x4 o1[8];
#pragma unroll
    for (int dt = 0; dt < 8; ++dt) o1[dt] = (f32x4){0.f, 0.f, 0.f, 0.f};
    float m1 = (w == 0) ? J.m0 : -1e30f, l1 = (w == 0 && g == 0) ? J.l0 : 0.f;
    bf16x8 kc[2][NDS], kn[2][NDS];
#define DK_LOADK(dst, kb_) do { _Pragma("unroll") for (int kt = 0; kt < 2; ++kt) { const int krow = (kb_) + 8 * (r >> 2) + 4 * kt + (r & 3); \
        const bf16_t* kp = J.K + (size_t)krow * J.ldk + g * 8; _Pragma("unroll") for (int ds = 0; ds < 4; ++ds) dst[kt][ds] = *(const bf16x8*)(kp + ds * 32); \
        if constexpr (DK == 192) { const bf16_t* kp2 = J.K2 + (size_t)krow * J.ldk2 + g * 8; dst[kt][4] = *(const bf16x8*)kp2; dst[kt][5] = *(const bf16x8*)(kp2 + 32); } } } while (0)
    int kb = J.k0 + 32 * w;
    if (kb < J.k1) DK_LOADK(kc, kb);
    for (; kb < J.k1; kb += 256) {
        const bool more = kb + 256 < J.k1;
        if (more) DK_LOADK(kn, kb + 256);
        const bf16_t* vb = J.ldv ? J.Vf + kb + (size_t)r * J.ldv + 8 * g : J.Vf + (size_t)(kb >> 5) * 4096 + lane * 8; const size_t vdt = J.ldv ? (size_t)16 * J.ldv : 512;
        bf16x8 vf[8];
#pragma unroll
        for (int dt = 0; dt < 8; ++dt) vf[dt] = *(const bf16x8*)(vb + dt * vdt);
        f32x4 s[2];
#pragma unroll
        for (int kt = 0; kt < 2; ++kt) { f32x4 acc0 = (f32x4){0.f, 0.f, 0.f, 0.f};
#pragma unroll
            for (int ds = 0; ds < NDS; ++ds) acc0 = __builtin_amdgcn_mfma_f32_16x16x32_bf16(kc[kt][ds], qf[0][ds], acc0, 0, 0, 0);
            if constexpr (DK == 192) {
                float ssq = 0.f;
#pragma unroll
                for (int ds = 0; ds < NDS; ++ds) { float f[8]; unpack8(__builtin_bit_cast(u32x4, kc[kt][ds]), f); ssq += sumsq8(f); }
                ssq = gsum4(ssq);
                const float rk = rsqrtf(ssq * (1.0f / 192.0f) + EPS);
                f32x4 rs; rs[0] = __shfl(rk, 4 * g); rs[1] = __shfl(rk, 4 * g + 1); rs[2] = __shfl(rk, 4 * g + 2); rs[3] = __shfl(rk, 4 * g + 3);
                acc0 *= rs; }
            s[kt] = acc0; }
        if (J.bias) {
#pragma unroll
            for (int kt = 0; kt < 2; ++kt)
#pragma unroll
                for (int j = 0; j < 4; ++j) s[kt][j] += J.bias[J.qpos0 - kb + 64 + r - (8 * g + 4 * kt + j)];
        }
        if (kb + 16 >= J.k1 && g >= 2) { s[0] = (f32x4){-1e30f, -1e30f, -1e30f, -1e30f}; s[1] = s[0]; }
        float mx = fmaxf(fmaxf(fmaxf(s[0][0], s[0][1]), fmaxf(s[0][2], s[0][3])), fmaxf(fmaxf(s[1][0], s[1][1]), fmaxf(s[1][2], s[1][3])));
        mx = gmax4(mx);
        const float mn = fmaxf(m1, mx), alpha = fexp2(m1 - mn); m1 = mn;
        float p[8];
#pragma unroll
        for (int j = 0; j < 4; ++j) { p[j] = fexp2(s[0][j] - mn); p[4 + j] = fexp2(s[1][j] - mn); }
        l1 = l1 * alpha + ((p[0] + p[1]) + (p[2] + p[3])) + ((p[4] + p[5]) + (p[6] + p[7]));
        const u32x4 pk = pack8(p); const bf16x8 pf = __builtin_bit_cast(bf16x8, pk);
#pragma unroll
        for (int dt = 0; dt < 8; ++dt) { f32x4 a2 = o1[dt] * alpha; o1[dt] = __builtin_amdgcn_mfma_f32_16x16x32_bf16(vf[dt], pf, a2, 0, 0, 0); }
        if (more) {
#pragma unroll
            for (int kt = 0; kt < 2; ++kt)
#pragma unroll
                for (int ds = 0; ds < NDS; ++ds) kc[kt][ds] = kn[kt][ds]; }
    }
#undef DK_LOADK
    float l = gsum4(l1);
    LAS unsigned char* my = c.lds + w * 16384;
#pragma unroll
    for (int dt = 0; dt < 8; ++dt) *(LAS f32x4*)(my + ((dt * 64 + lane) << 4)) = o1[dt];
    *(LAS float*)(my + 8192 + lane * 4) = m1; *(LAS float*)(my + 8448 + lane * 4) = l;
    __syncthreads();
    float mv[8], M = -1e30f;
#pragma unroll
    for (int v = 0; v < 8; ++v) { mv[v] = *(LAS const float*)(c.lds + v * 16384 + 8192 + lane * 4); M = fmaxf(M, mv[v]); }
    float L = 0.f; f32x4 acc = (f32x4){0.f, 0.f, 0.f, 0.f};
#pragma unroll
    for (int v = 0; v < 8; ++v) { const float sc = fexp2(mv[v] - M); L += sc * *(LAS const float*)(c.lds + v * 16384 + 8448 + lane * 4);
        acc += *(LAS const f32x4*)(c.lds + v * 16384 + ((w * 64 + lane) << 4)) * sc; }
    if (r < J.nq) {
        const float inv = 1.0f / L;
        const u32x2 gv = *(const u32x2*)(J.gate + (size_t)r * J.ldg + w * 16 + 4 * g);
        float gt[4] = {bflo(gv.x), bfhi(gv.x), bflo(gv.y), bfhi(gv.y)}, ov[4];
#pragma unroll
        for (int j = 0; j < 4; ++j) { const float sg = gt[j] / (1.0f + __expf(-gt[j])); ov[j] = acc[j] * inv * sg; }
        *(u32x2*)(J.O + (size_t)r * J.ldo + w * 16 + 4 * g) = (u32x2){cvt_pk_bf16(ov[0], ov[1]), cvt_pk_bf16(ov[2], ov[3])};
    }
    __syncthreads();
}

__device__ __forceinline__ void attn_phase(const Ctx& c, int l, int round) {
    const int kind = l % 3;
    bf16_t* O = c.wsb(WS_XN);
    const bool r1 = (kind == 1 && round == 1);
    const int n_dec = (kind == 1) ? (r1 ? 96 : 0) : 96, n_xd = r1 ? 0 : 32, n_mix = r1 ? 0 : 768, n_xp = r1 ? 0 : 256;
    const int ntot = n_dec + n_xd + n_mix + n_xp;
    LayerAC L = layer_ac(c, kind == 1 ? 0 : l);
    const bf16_t* Z = (kind == 1) ? c.wsb(WS_DYN + DY_ZB) : L.Z; const int ldz = (kind == 1) ? ZB_LD : L.ldz, xo = (kind == 1) ? ZB_XQ : L.xo, go = (kind == 1) ? ZB_G : L.go;
    const int w = c.wid;
    unsigned* qctr = (unsigned*)(c.p.ws + WS_BAR) + 3520 + ((l * 2 + round) * 8 + (c.bx & 7)) * 4;
    volatile LAS unsigned* qslot = (volatile LAS unsigned*)(c.lds + 131072 + 64);
    const bool useq = (c.G % 8) == 0;
    if (c.tid == 0) qslot[0] = useq ? atomicAdd(qctr, 1u) : 0u;
    for (int it = 0;; ++it) {
        __syncthreads();
        const int kq = __builtin_amdgcn_readfirstlane((int)qslot[it & 1]);
        const int u0 = useq ? (int)(c.bx & 7) + 8 * kq : c.bx + it * c.G;
        if (u0 >= ntot) break;
        if (useq && c.tid == 0) qslot[(it + 1) & 1] = atomicAdd(qctr, 1u);
        int u = u0; AttnJob J; J.K2 = nullptr; J.ldk2 = 0; J.krstd = nullptr; J.bias = nullptr; J.tbw = 0; J.qpos0 = 0; J.m0 = -1e30f; J.l0 = 0.f; J.ldg = ldz; J.ldo = DM; J.nq = 32; J.k0 = 0; J.ldv = 0;
        J.qgain = (kind == 1) ? c.p.in[27] : L.gq; J.qgain2 = c.p.in[28]; J.qpos = 0;
        bool dk192 = false;
        if (u < n_dec + n_xd) {
            J.nq = DEC;
            if (u < n_dec) {
                const int b = u / 12, h = u % 12; const size_t row0 = NP + b * DEC;
                J.gate = Z + row0 * ldz + go + h * 128; J.O = O + row0 * DM + h * 128;
                if (kind == 1) {
                    dk192 = true;
                    J.Q = c.wsb(WS_DYN + DY_QB) + row0 * 2304 + h * 192; J.ldq = 2304; J.K = c.wsb(WS_DYN + DY_KDEC) + (size_t)b * KVB * 1536 + h * 128; J.ldk = 1536;
                    J.K2 = c.wsb(WS_KRD) + (size_t)b * KVB * 64; J.ldk2 = 64; J.Vf = c.wsb(WS_DYN + DY_VDEC) + (size_t)h * 128 * KVB_ROWS + (size_t)b * KVB; J.ldv = KVB_ROWS; J.krstd = c.wsf(WS_RSTDD) + (size_t)(b * 12 + h) * RSD_LD;
                    J.k1 = KVB; J.qpos = PAST;
                } else {
                    const int kvh = (kind == 0) ? h / 3 : h, nk = L.nkh * 128;
                    J.Q = Z + row0 * ldz + h * 128; J.ldq = ldz; J.K = L.Kdec + (size_t)b * L.kdrows * nk + kvh * 128; J.ldk = nk; J.Vf = L.Vfdec + (size_t)((b * L.nkh + kvh) * L.nblk) * 4096;
                    J.bias = L.tb + h * L.tbw; J.qpos0 = L.past; J.k1 = L.past + DEC;
                    if (L.sink) { J.m0 = L.sink[h] * LOG2E; J.l0 = 1.f; }
                }
            } else {
                u -= n_dec; const int b = u / 4, h = u % 4; const size_t row0 = NP + b * DEC; J.qgain = c.p.in[16] + l * 128;
                J.Q = Z + row0 * ldz + xo + h * 128; J.ldq = ldz; J.K = c.wsb(WS_KCMEM) + ((size_t)(l * 8 + b) * 256) * 512 + h * 128; J.ldk = 512; J.Vf = c.wsb(WS_VFCMEM) + (size_t)(((l * 8 + b) * 4 + h) * 8) * 4096;
                J.k1 = 256; J.gate = Z + row0 * ldz + go + 1536 + h * 128; J.O = O + row0 * DM + 1536 + h * 128;
            }
            if (dk192) { MKCTXN(cc); attn_split<192>(cc, J); } else { MKCTXN(cc); attn_split<128>(cc, J); }
            continue;
        }
        u -= n_dec + n_xd;
        SJob S; S.K2 = nullptr; S.ldk2 = 0; S.rs = nullptr; S.ldv = 0;
        if (u < n_mix) {
            int bh, qb8;
            if (kind == 1) {
                const int li = u;
                qb8 = 7 - li / 96; bh = li % 96;
            } else { const int k = u >> 8, x = u & 7, y = (u & 255) >> 3; bh = k * 32 + x * 4 + (y >> 3); qb8 = y & 7; }
            const int b = bh / 12, h = bh % 12, qb = qb8 * 8 + w, ch = qb >> 1; const size_t row0 = (size_t)b * SEQ + qb * 32;
            J.gate = Z + row0 * ldz + go + h * 128; J.O = O + row0 * DM + h * 128; J.k1 = (ch + 1) * 64; S.K1 = (qb8 * 4 + 4) * 64;
            if (kind == 1) {
                dk192 = true;
                J.Q = c.wsb(WS_DYN + DY_QB) + row0 * 2304 + h * 192; J.ldq = 2304; S.K = c.wsb(WS_DYN + DY_KP) + (size_t)b * SEQ * 1536 + h * 128; S.ldk = 1536;
                S.K2 = c.wsb(WS_DYN + DY_KRP) + (size_t)b * SEQ * 64; S.ldk2 = 64; S.Vf = c.wsb(WS_DYN + DY_VP) + (size_t)h * 128 * NP + (size_t)b * SEQ; S.ldv = NP; S.rs = c.wsf(WS_DYN + DY_RSTDP) + (size_t)bh * SEQ;
                S.K0 = 0; J.qpos = qb * 32;
            } else {
                const int kvh = (kind == 0) ? h / 3 : h, nprev = (kind == 0) ? 2 : 8, c0 = qb8 * 4;
                J.Q = Z + row0 * ldz + h * 128; J.ldq = ldz; S.K = Z + (size_t)b * SEQ * ldz + L.ko + kvh * 128; S.ldk = ldz; S.Vf = L.Vf + (size_t)((b * L.nkh + kvh) * 64) * 4096;
                J.bias = L.tb + h * L.tbw; J.tbw = L.tbw; J.qpos0 = qb * 32; J.k0 = (ch > nprev ? ch - nprev : 0) * 64; S.K0 = (c0 > nprev ? c0 - nprev : 0) * 64;
                if (L.sink) { J.m0 = L.sink[h] * LOG2E; J.l0 = 1.f; }
            }
        } else {
            J.qgain = c.p.in[16] + l * 128;
            u -= n_mix; const int x = u & 7, y = u >> 3, qb8 = y & 7, bh = x * 4 + (y >> 3), b = bh / 4, h = bh % 4, qb = qb8 * 8 + w; const size_t row0 = (size_t)b * SEQ + qb * 32;
            J.Q = Z + row0 * ldz + xo + h * 128; J.ldq = ldz; S.K = c.wsb(WS_KMEM) + ((size_t)(l * 8 + b) * 256) * 512 + h * 128; S.ldk = 512; S.Vf = c.wsb(WS_VFMEM) + (size_t)(((l * 8 + b) * 4 + h) * 8) * 4096;
            S.K0 = 0; S.K1 = 256; J.k1 = 256; J.gate = Z + row0 * ldz + go + 1536 + h * 128; J.O = O + row0 * DM + 1536 + h * 128;
        }
        if (dk192) { MKCTXN(cc); attn_shared<192>(cc, S, J); } else { MKCTXN(cc); attn_shared<128>(cc, S, J); }
    }
}

#define XB_TMO      128
#define XB_XCNT(j)  (256  + 64 * (j))
#define XB_XSUB(j)  (1280 + 64 * (j))
#define XB_XGEN(j)  (2304 + 64 * (j))
#define XB_TOP      3328
#define XB_TOPGEN   3392
#define XCD_BAR_WORDS 3456
#define XB_SPIN_CAP (1u << 22)
__device__ __forceinline__ unsigned xb_ld(unsigned* p)              { return __hip_atomic_load(p, __ATOMIC_RELAXED, __HIP_MEMORY_SCOPE_AGENT); }
__device__ __forceinline__ unsigned xb_add(unsigned* p, unsigned v) { return __hip_atomic_fetch_add(p, v, __ATOMIC_RELAXED, __HIP_MEMORY_SCOPE_AGENT); }
__device__ __forceinline__ unsigned xb_xcc_id() { return (unsigned)__builtin_amdgcn_s_getreg((3 << 11) | 20) & 0xFu; }
#define XB_SPIN(cond, bar) do { unsigned _sp = 0; while (cond) {   \
    if ((++_sp & 255u) == 0u) { if (xb_ld(&(bar)[XB_TMO])) break; if (_sp > XB_SPIN_CAP) { atomicAdd(&(bar)[XB_TMO], 1u); break; } } } } while (0)
struct XcdBarrier { unsigned* bar; unsigned x; volatile LAS unsigned* st; };
__device__ __forceinline__ XcdBarrier xcd_barrier_post(unsigned* bar, volatile LAS unsigned* st) {
    XcdBarrier b; b.bar = bar; b.x = xb_xcc_id(); b.st = st;
    if (threadIdx.x == 0) (void)xb_add(&bar[XB_XCNT(b.x)], 1u);
    return b;
}
__device__ __forceinline__ void xcd_barrier_complete(unsigned* bar, unsigned x, unsigned& nloc, unsigned& nx) {
    const unsigned G = gridDim.x * gridDim.y * gridDim.z;
    unsigned sum, cnt, mine, sp = 0u;
    for (;;) {
        sum = 0u; cnt = 0u; mine = 0u;
#pragma unroll
        for (unsigned j = 0; j < 16; ++j) { const unsigned c = xb_ld(&bar[XB_XCNT(j)]); sum += c; cnt += (c > 0u) ? 1u : 0u; mine = (j == x) ? c : mine; }
        if (sum == G) break;
        __builtin_amdgcn_s_sleep(1);
        if ((++sp & 255u) == 0u) { if (xb_ld(&bar[XB_TMO])) break; if (sp > XB_SPIN_CAP) { atomicAdd(&bar[XB_TMO], 1u); break; } }
    }
    nloc = mine > 0u ? mine : 1u; nx = cnt > 0u ? cnt : 1u;
}
__device__ __forceinline__ void xcd_barrier(const XcdBarrier& b) {
    asm volatile("s_waitcnt vmcnt(0)" ::: "memory");
#ifdef PARANOID_BAR
    __builtin_amdgcn_fence(__ATOMIC_RELEASE, "agent");
    asm volatile("s_waitcnt vmcnt(0)" ::: "memory");
#endif
    __syncthreads();
    if (threadIdx.x == 0) {
        unsigned* bar = b.bar;
        __builtin_amdgcn_s_waitcnt(0);
        unsigned nloc = b.st[0], nx = b.st[1];
        if (nloc == 0u) { xcd_barrier_complete(bar, b.x, nloc, nx); b.st[0] = nloc; b.st[1] = nx; }
        const unsigned old = xb_add(&bar[XB_XSUB(b.x)], 1u);
        const unsigned gen = old / nloc;
        if (old + 1u == (gen + 1u) * nloc) {
            __builtin_amdgcn_fence(__ATOMIC_RELEASE, "agent");
            asm volatile("s_waitcnt vmcnt(0)" ::: "memory");
            const unsigned og = xb_add(&bar[XB_TOP], 1u);
            const unsigned tg = og / nx;
            if (og + 1u == (tg + 1u) * nx) xb_add(&bar[XB_TOPGEN], 1u);
            else XB_SPIN(xb_ld(&bar[XB_TOPGEN]) == tg, bar);
            __builtin_amdgcn_fence(__ATOMIC_ACQUIRE, "agent");
            xb_add(&bar[XB_XGEN(b.x)], 1u);
            asm volatile("s_waitcnt vmcnt(0)" ::: "memory");
        } else {
            XB_SPIN(xb_ld(&bar[XB_XGEN(b.x)]) == gen, bar);
            __builtin_amdgcn_fence(__ATOMIC_ACQUIRE, "agent");
            asm volatile("s_waitcnt vmcnt(0)" ::: "memory");
        }
    }
    __syncthreads();
#ifdef PARANOID_BAR
    __builtin_amdgcn_fence(__ATOMIC_ACQUIRE, "agent");
    asm volatile("s_waitcnt vmcnt(0)" ::: "memory");
    __syncthreads();
#endif
}

enum { GL_MEM = 0, GL_IN = 1, GL_OUT = 2, GL_B1 = 3, GL_B2 = 4, GL_MEMIN = 5 };
__device__ __forceinline__ bool get_gemm(const Ctx& c, int list, int l, int i, GemmDesc& d) {
    const int kind = l % 3;
    d.epi = 0; d.mvalid = 0; d.R = nullptr; d.rbf = 0; d.cbf = 0; d.sBm = 0; d.sCm = 0; d.rot = 0;
    if (list == GL_MEMIN) { if (i == 0) { list = GL_MEM; d.rot = 128; } else { list = GL_IN; --i; } }
    if (list == GL_MEM) { if (i) return false; d.A = c.wsb(WS_DYN + DY_MEMN); d.lda = 2048; d.Bt = c.wsb(WS_DYN + DY_WMEM); d.ldb = 2048; d.C = c.wsb(WS_DYN + DY_ZM); d.ldc = 4096; d.nM = 8; d.nN = 16; d.K = 2048; return true; }
    if (list == GL_IN) { if (i) return false; d.A = c.wsb(WS_XN); d.lda = 2048; d.Bt = c.wsb(WS_WIN); d.ldb = 2048; d.K = 2048; d.nM = 65;
        if (kind == 0) { d.C = c.wsb(WS_DYN); d.ldc = 5120; d.nN = 20; } else if (kind == 1) { d.C = c.wsb(WS_DYN + DY_ZB); d.ldc = ZB_LD; d.nN = 14; } else { d.C = c.wsb(WS_DYN); d.ldc = 7168; d.nN = 28; }
        return true; }
    if (list == GL_OUT) {
        if (i > 1) return false; d.Bt = c.wsb(WS_WOUT); d.ldb = 2048; d.lda = 2048; d.ldc = 2048; d.nN = 8;
        if (i == 0) { d.A = c.wsb(WS_XN); d.K = 2048; d.nM = 64; d.epi = 1; d.mvalid = NP; d.sAm = (size_t)256 * 2048 * 2;
            d.rbf = (l != 0); d.cbf = (l != 3);
            d.R = (l == 0) ? (const void*)c.p.in[0] : (l == 3 ? (const void*)c.wsb(WS_DYN + 200 * MiB) : (const void*)c.p.out);
            d.C = (l == 3) ? (void*)c.p.out : (l == 2 ? (void*)c.wsb(WS_DYN + 200 * MiB) : (void*)c.p.out); }
        else { d.A = c.wsb(WS_XN) + (size_t)NP * 2048; d.K = 256; d.nM = 8; d.C = c.wsf(WS_PART); d.epi = 3; d.sAm = 512; d.sBm = 512; d.sCm = (size_t)128 * 2048; }
        return true; }
    if (list == GL_B1) {
        if (i == 0) { d.A = c.wsb(WS_DYN + DY_ZB); d.lda = ZB_LD; d.Bt = c.wsb(WS_WQB); d.ldb = 512; d.K = 512; d.nM = 65; d.nN = 9; d.C = c.wsb(WS_DYN + DY_QB); d.ldc = 2304; return true; }
        if (i > 2) return false;
        d.K = 256;
        if (i == 1) { d.A = c.wsb(WS_DYN + DY_ZB) + ZB_CKV; d.lda = ZB_LD; d.Bt = c.wsb(WS_WK); d.ldb = 256; d.nM = 64; d.nN = 6; d.C = c.wsb(WS_DYN + DY_KP); d.ldc = 1536; }
        else { d.A = c.wsb(WS_WV); d.lda = 256; d.Bt = c.wsb(WS_DYN + DY_ZB) + ZB_CKV; d.ldb = ZB_LD; d.nM = 6; d.nN = 64; d.C = c.wsb(WS_DYN + DY_VP); d.ldc = NP; }
        return true;
    }
    if (i > 1) return false;
    d.K = 256;
    if (i == 0) { d.A = c.wsb(WS_CKVD); d.lda = 256; d.Bt = c.wsb(WS_WK); d.ldb = 256; d.nM = 129; d.nN = 6; d.C = c.wsb(WS_DYN + DY_KDEC); d.ldc = 1536; }
    else { d.A = c.wsb(WS_WV); d.lda = 256; d.Bt = c.wsb(WS_CKVD); d.ldb = 256; d.nM = 6; d.nN = 129; d.C = c.wsb(WS_DYN + DY_VDEC); d.ldc = KVB_ROWS; }
    return true;
}

enum { OP_PRO = 0, OP_NPH, OP_GEMM, OP_MEMP_GEMM, OP_POSTAC, OP_POST1B, OP_POST2B, OP_ATT, OP_FIN };
struct Step { unsigned char op, l, a; };
__device__ const Step PROG[] = {
    {OP_PRO, 0, 0},
    {OP_GEMM, 0, GL_MEMIN}, {OP_POSTAC, 0, 1}, {OP_ATT, 0, 0}, {OP_GEMM, 0, GL_OUT},
    {OP_NPH, 1, 0}, {OP_GEMM, 1, GL_IN}, {OP_POST1B, 1, 0}, {OP_GEMM, 1, GL_B1}, {OP_POST2B, 1, 0}, {OP_ATT, 1, 0}, {OP_GEMM, 1, GL_B2}, {OP_ATT, 1, 1}, {OP_GEMM, 1, GL_OUT},
    {OP_NPH, 2, 0}, {OP_GEMM, 2, GL_IN}, {OP_POSTAC, 2, 0}, {OP_ATT, 2, 0}, {OP_GEMM, 2, GL_OUT},
    {OP_NPH, 3, 0}, {OP_GEMM, 3, GL_IN}, {OP_POSTAC, 3, 0}, {OP_ATT, 3, 0}, {OP_GEMM, 3, GL_OUT}, {OP_FIN, 3, 0},
};
#ifndef ATT_REP
#define ATT_REP 1
#endif
#ifndef GEMM_REP
#define GEMM_REP 1
#endif
#ifndef NPH_REP
#define NPH_REP 1
#endif
#ifndef ATT_REP_STEP
#define ATT_REP_STEP -1
#endif
#ifndef NRUN
#define NRUN 99
#endif
constexpr int NSTEPS = (NRUN < (int)(sizeof(PROG) / sizeof(Step))) ? NRUN : (int)(sizeof(PROG) / sizeof(Step));

__global__ void __launch_bounds__(512, 2) fwd_megakernel(KP p) {
    extern __shared__ __attribute__((aligned(16))) unsigned char smem[];
    KPP kp0 = (KPP)__builtin_amdgcn_kernarg_segment_ptr();
    volatile LAS unsigned* st = (volatile LAS unsigned*)((LAS unsigned char*)smem + 131072);
    if (threadIdx.x < 16) st[threadIdx.x] = 0u;
    __syncthreads();
    const XcdBarrier bar = xcd_barrier_post((unsigned*)(kp0->ws + WS_BAR), st);
    for (int st = 0; st < NSTEPS; ++st) {
        const int op = PROG[st].op, l = PROG[st].l, a = PROG[st].a;
        if (op == OP_PRO) { MKCTX; prologue(c); }
        else if (op == OP_NPH) { MKCTX; for (int rep = 0; rep < NPH_REP; ++rep) nphase(c, l); }
        else if (op == OP_POSTAC) { if (a) { MKCTX; memp(c); } MKCTX; post_ac(c, l); }
        else if (op == OP_POST1B) { MKCTX; post1_b(c, l); }
        else if (op == OP_FIN) { MKCTX;
            for (int rr = c.gw; rr < NB * DEC; rr += c.NW) { float* y = c.p.out + (size_t)(NP + rr) * DM; const float* part = c.wsf(WS_PART) + (size_t)rr * DM;
                f32x4 v[8];
#pragma unroll
                for (int i = 0; i < 8; ++i) v[i] = *(const f32x4*)(y + i * 256 + c.lane * 4);
                for (int ks = 0; ks < 8; ++ks)
#pragma unroll
                    for (int i = 0; i < 8; ++i) v[i] += *(const f32x4*)(part + (size_t)ks * 128 * 2048 + i * 256 + c.lane * 4);
#pragma unroll
                for (int i = 0; i < 8; ++i) *(f32x4*)(y + i * 256 + c.lane * 4) = v[i]; } }
        else if (op == OP_POST2B) { MKCTX; post2_b(c, a); }
        else if (op == OP_ATT) { for (int rep = 0; rep < ((st == ATT_REP_STEP) ? 2 : ATT_REP); ++rep) { MKCTX; attn_phase(c, l, a); } }
        else {
            if (op == OP_MEMP_GEMM) { MKCTX; memp(c); __syncthreads(); }
            MKCTX;
            GemmDesc d;
            for (int rep = 0; rep < (a == GL_OUT ? 1 : GEMM_REP); ++rep)
            for (int i = 0; (d.sAm = 0, get_gemm(c, a, l, i, d)); ++i) { if (d.sAm == 0) d.sAm = (size_t)256 * d.lda * 2; pg8::StaticOrder S; S.init(d.nM, d.nN, c.G, (c.bx + c.G - d.rot) % c.G); pg8::gemm_phase(c.lds, d, S); }
        }
        if (st + 1 < NSTEPS) xcd_barrier(bar);
    }
    asm volatile("s_waitcnt vmcnt(0)" ::: "memory");
    __syncthreads();
    if (threadIdx.x == 0) { __builtin_amdgcn_fence(__ATOMIC_RELEASE, "agent"); asm volatile("s_waitcnt vmcnt(0)" ::: "memory"); }
}

extern "C" void kernel_launch(void* const* d_in, const int* in_sizes, int n_in, void* d_out, int out_size, void* d_ws, size_t ws_size, hipStream_t stream) {
    static int grid_blocks = 0;
    constexpr size_t kDynLds = 131072 + 256;
    if (grid_blocks == 0) {
        if (n_in != 33 || (size_t)out_size != O_END || ws_size < WS_NEED) { fprintf(stderr, "kernel_launch: unexpected shapes n_in %d out %d ws %zu (need %zu)\n", n_in, out_size, ws_size, (size_t)WS_NEED); grid_blocks = -1; return; }
        int dev = 0, cus = 0, per_cu = 0;
        hipGetDevice(&dev);
        hipDeviceGetAttribute(&cus, hipDeviceAttributeMultiprocessorCount, dev);
        hipFuncSetAttribute((const void*)fwd_megakernel, hipFuncAttributeMaxDynamicSharedMemorySize, (int)kDynLds);
        hipOccupancyMaxActiveBlocksPerMultiprocessor(&per_cu, (const void*)fwd_megakernel, 512, kDynLds);
        if (per_cu < 1) per_cu = 1;
        if (per_cu > 1) per_cu = 1;
        grid_blocks = cus * per_cu;
        (void)hipGetLastError();
    }
    if (grid_blocks < 0) return;
    if (hipMemsetAsync((char*)d_ws + WS_BAR, 0, 16384, stream) != hipSuccess) { fprintf(stderr, "kernel_launch: memset failed\n"); return; }
    KP p{};
    for (int i = 0; i < 33; ++i) p.in[i] = (const float*)d_in[i];
    p.out = (float*)d_out; p.ws = (unsigned char*)d_ws;
    void* args[] = {&p};
    hipError_t e = hipLaunchCooperativeKernel((const void*)fwd_megakernel, dim3(grid_blocks), dim3(512), args, kDynLds, stream);
    if (e != hipSuccess) fprintf(stderr, "cooperative launch failed: %s (grid %d)\n", hipGetErrorString(e), grid_blocks);
}
```
